# Optimizing an MI355X kernel written in HIP

```python
import jax, jax.numpy as jnp
from jax import lax
import numpy as np

D_MODEL = 1024
BATCH = 8
SEQ = 8192
DEPTH = 1

CTX_LEN = 256
GRID_W = 64
CHUNK = 64
EPS = 1e-6

GLA_HEADS = 4
GLA_QK = D_MODEL // 2
GLA_V = D_MODEL
GLA_DK = GLA_QK // GLA_HEADS
GLA_DV = GLA_V // GLA_HEADS
GLA_LOWRANK = 16
GLA_GATE_NORM = 16.0

GDN_DK = 128
GDN_DV = 128
GDN_HEADS = D_MODEL // GDN_DV
GDN_QK = GDN_HEADS * GDN_DK
GDN_V = GDN_HEADS * GDN_DV
CONV_W = 5

_FFN_RAW = -(-8 * D_MODEL // 3)
FFN_HIDDEN = -(-_FFN_RAW // 256) * 256

SPLITS = (GLA_QK, GLA_QK, GLA_V, GLA_V, GLA_LOWRANK, GLA_LOWRANK,
          GDN_QK, GDN_QK, GDN_V, GDN_V, 4 * GDN_HEADS,
          D_MODEL, D_MODEL)
P_IN = sum(SPLITS)

kernel_name = 'hybrid_gla_gdn_prefix_dit_block'


def rmsnorm(t, w):
    tf = t.astype(jnp.float32)
    y = tf * lax.rsqrt(jnp.mean(tf * tf, axis=-1, keepdims=True) + EPS)
    return y.astype(t.dtype) * w


def l2norm(t):
    tf = t.astype(jnp.float32)
    return (tf * lax.rsqrt(jnp.sum(tf * tf, axis=-1, keepdims=True) + EPS)).astype(t.dtype)


def modulate(t, shift, scale):
    return t * (1 + scale) + shift


def split_cols(p):
    points = [int(s) for s in np.cumsum(SPLITS)[:-1]]
    return jnp.split(p, points, axis=-1)


def to_heads(t, n_heads):
    B, L, W = t.shape
    return t.reshape(B, L, n_heads, W // n_heads).transpose(0, 2, 1, 3)


def from_heads(t):
    B, H, L, d = t.shape
    return t.transpose(0, 2, 1, 3).reshape(B, L, H * d)


def to_chunks(t):
    B, H, L = t.shape[:3]
    t = t.reshape(B, H, L // CHUNK, CHUNK, *t.shape[3:])
    return jnp.moveaxis(t, 2, 0)


def from_chunks(t):
    t = jnp.moveaxis(t, 0, 2)
    B, H, n, C = t.shape[:4]
    return t.reshape(B, H, n * C, *t.shape[4:])


def to_column_major(t):
    B, L, C = t.shape
    rows = L // GRID_W
    return t.reshape(B, rows, GRID_W, C).transpose(0, 2, 1, 3)


def from_column_major(t):
    B, L, C = t.shape
    rows = L // GRID_W
    return t.reshape(B, GRID_W, rows, C).transpose(0, 2, 1, 3).reshape(B, L, C)


def centred_dwconv(t, w):
    pad = CONV_W // 2
    L = t.shape[-2]
    tp = jnp.pad(t, [(0, 0)] * (t.ndim - 2) + [(pad, pad), (0, 0)])
    return sum(w[i] * tp[..., i:i + L, :] for i in range(CONV_W))


def gla_scan(q, k, v, g, s0):
    out_dtype = v.dtype
    q, k, v, g = (t.astype(jnp.float32) for t in (q, k, v, g))
    incl = jnp.tril(jnp.ones((CHUNK, CHUNK), dtype=bool))

    def step(S, inp):
        qc, kc, vc, gc = inp
        G = jnp.cumsum(gc, axis=-2)
        diff = G[..., :, None, :] - G[..., None, :, :]
        decay = jnp.exp(jnp.where(incl[:, :, None], diff, -jnp.inf))
        A = jnp.einsum('bhid,bhjd,bhijd->bhij', qc, kc, decay)
        o = (jnp.einsum('bhij,bhjv->bhiv', A, vc)
             + jnp.einsum('bhid,bhdv->bhiv', qc * jnp.exp(G), S))
        G_end = G[..., -1, :]
        S = (jnp.exp(G_end)[..., None] * S
             + jnp.einsum('bhjd,bhjv->bhdv', kc * jnp.exp(G_end[..., None, :] - G), vc))
        return S, o

    S, o = lax.scan(step, s0.astype(jnp.float32), tuple(to_chunks(t) for t in (q, k, v, g)))
    return S, from_chunks(o).astype(out_dtype)


def gdn_scan(q, k, v, g, beta, s0):
    out_dtype = v.dtype
    q, k, v, g, beta = (to_chunks(t.astype(jnp.float32)) for t in (q, k, v, g, beta))
    strict = jnp.tril(jnp.ones((CHUNK, CHUNK), dtype=bool), -1)
    incl = jnp.tril(jnp.ones((CHUNK, CHUNK), dtype=bool))
    G = jnp.cumsum(g, axis=-1)
    diff = G[..., :, None] - G[..., None, :]
    kk = jnp.einsum('nbhid,nbhjd->nbhij', k, k)
    Lmat = beta[..., :, None] * kk * jnp.exp(jnp.where(strict, diff, -jnp.inf))
    T = Lmat + jnp.eye(CHUNK, dtype=jnp.float32)
    u = lax.linalg.triangular_solve(T, beta[..., None] * v, left_side=True, lower=True, unit_diagonal=True)
    w = lax.linalg.triangular_solve(T, (beta * jnp.exp(G))[..., None] * k, left_side=True, lower=True, unit_diagonal=True)
    Aqk = jnp.einsum('nbhid,nbhjd->nbhij', q, k) * jnp.exp(jnp.where(incl, diff, -jnp.inf))
    q_dec = q * jnp.exp(G)[..., None]
    G_end = G[..., -1]
    k_dec = k * jnp.exp(G_end[..., None] - G)[..., None]

    def step(S, inp):
        u_c, w_c, A_c, qd, kd, ge = inp
        v_new = u_c - jnp.einsum('bhid,bhdv->bhiv', w_c, S)
        o = jnp.einsum('bhid,bhdv->bhiv', qd, S) + jnp.einsum('bhij,bhjv->bhiv', A_c, v_new)
        S = jnp.exp(ge)[..., None, None] * S + jnp.einsum('bhjd,bhjv->bhdv', kd, v_new)
        return S, o

    S, o = lax.scan(step, s0.astype(jnp.float32), (u, w, Aqk, q_dec, k_dec, G_end))
    return S, from_chunks(o).astype(out_dtype)


def _identity(t):
    return t


def _reverse(t):
    return jnp.flip(t, axis=2)


def bidirectional(scan_fn, ctx_qkv, ctx_gates, lat_qkv, lat_gates, s0):
    outs_c, outs_l = [], []
    for direction, rev in enumerate((_identity, _reverse)):
        s_ctx, o_c = scan_fn(*(rev(t) for t in ctx_qkv), *(rev(t) for t in ctx_gates[direction]), s0)
        _, o_l = scan_fn(*(rev(t) for t in lat_qkv), *(rev(t) for t in lat_gates[direction]), s_ctx)
        outs_c.append(rev(o_c))
        outs_l.append(rev(o_l))
    return outs_c[0] + outs_c[1], outs_l[0] + outs_l[1]


def gla_prepare(q, k, v, lr_f, lr_b, lr_w, lr_bias):
    q = to_heads(q * GLA_DK ** -0.5, GLA_HEADS)
    k = to_heads(k, GLA_HEADS)
    v = to_heads(v, GLA_HEADS)
    gates = tuple(
        (to_heads(jax.nn.log_sigmoid((lr @ lr_w[d] + lr_bias[d]).astype(jnp.float32)) / GLA_GATE_NORM, GLA_HEADS),)
        for d, lr in enumerate((lr_f, lr_b)))
    return (q, k, v), gates


def gdn_prepare(q, k, v, ab, conv_w, a_log, dt_bias, column_major):
    B, L, _ = q.shape
    qkv = jnp.concatenate([q, k, v], axis=-1)
    if column_major:
        qkv = centred_dwconv(to_column_major(qkv), conv_w).reshape(B, L, -1)
        ab = to_column_major(ab).reshape(B, L, -1)
    else:
        qkv = centred_dwconv(qkv, conv_w)
    qkv = jax.nn.silu(qkv)
    q, k, v = jnp.split(qkv, [GDN_QK, 2 * GDN_QK], axis=-1)
    q = l2norm(to_heads(q, GDN_HEADS)) * GDN_DK ** -0.5
    k = l2norm(to_heads(k, GDN_HEADS))
    v = to_heads(v, GDN_HEADS)
    a_f, a_b, b_f, b_b = jnp.split(ab, 4, axis=-1)
    gates = tuple(
        ((-jnp.exp(a_log[d]) * jax.nn.softplus(a.astype(jnp.float32) + dt_bias[d])).transpose(0, 2, 1),
         jax.nn.sigmoid(b.astype(jnp.float32)).transpose(0, 2, 1))
        for d, (a, b) in enumerate(((a_f, b_f), (a_b, b_b))))
    return (q, k, v), gates


def head_norm_gate(o, gain, z):
    B, L, _ = o.shape
    H, dv = gain.shape
    of = o.astype(jnp.float32).reshape(B, L, H, dv)
    y = (of * lax.rsqrt(jnp.mean(of * of, axis=-1, keepdims=True) + EPS)).astype(z.dtype) * gain
    return y.reshape(B, L, H * dv) * jax.nn.silu(z)


def token_mixers(h_c, h_l, w_in, lr_w, lr_bias, gla_gain, conv_w, a_log, dt_bias, gdn_gain, w_out, need_ctx):
    B = h_l.shape[0]
    pc = split_cols(h_c @ w_in)
    pl = split_cols(h_l @ w_in)
    gc_qkv, gc_g = gla_prepare(pc[0], pc[1], pc[2], pc[4], pc[5], lr_w, lr_bias)
    gl_qkv, gl_g = gla_prepare(pl[0], pl[1], pl[2], pl[4], pl[5], lr_w, lr_bias)
    s0_gla = jnp.zeros((B, GLA_HEADS, GLA_DK, GLA_DV), jnp.float32)
    o_gla_c, o_gla_l = bidirectional(gla_scan, gc_qkv, gc_g, gl_qkv, gl_g, s0_gla)
    dc_qkv, dc_g = gdn_prepare(pc[6], pc[7], pc[8], pc[10], conv_w, a_log, dt_bias, False)
    dl_qkv, dl_g = gdn_prepare(pl[6], pl[7], pl[8], pl[10], conv_w, a_log, dt_bias, True)
    s0_gdn = jnp.zeros((B, GDN_HEADS, GDN_DK, GDN_DV), jnp.float32)
    o_gdn_c, o_gdn_l = bidirectional(gdn_scan, dc_qkv, dc_g, dl_qkv, dl_g, s0_gdn)
    o_gdn_l = from_column_major(from_heads(o_gdn_l))

    def merge(p, o_gla, o_gdn):
        y_gla = head_norm_gate(o_gla, gla_gain, p[3])
        y_gdn = head_norm_gate(o_gdn, gdn_gain, p[9])
        return (jax.nn.sigmoid(p[11]) * y_gla + jax.nn.sigmoid(p[12]) * y_gdn) @ w_out

    y_l = merge(pl, from_heads(o_gla_l), o_gdn_l)
    y_c = merge(pc, from_heads(o_gla_c), from_heads(o_gdn_c)) if need_ctx else None
    return y_c, y_l


def swiglu(t, w_gate, w_up, w_down):
    return (jax.nn.silu(t @ w_gate) * (t @ w_up)) @ w_down


def setup_inputs(seed: int = 0) -> dict:
    key = jax.random.key(seed)
    ks = jax.random.split(key, 24)
    f32 = jnp.float32

    def nrm(k, shape, fan_in):
        return jax.random.normal(k, shape, f32) * fan_in ** -0.5

    def gain(k, shape):
        return 1.0 + 0.02 * jax.random.normal(k, shape, f32)

    dt = jnp.exp(jax.random.uniform(ks[14], (DEPTH, 2, GDN_HEADS), f32, np.log(1e-3), np.log(1e-1)))
    return {
        'x': jax.random.normal(ks[0], (BATCH, SEQ, D_MODEL), f32),
        'c': jax.random.normal(ks[1], (BATCH, D_MODEL), f32),
        'ctx': jax.random.normal(ks[2], (BATCH, CTX_LEN, D_MODEL), f32),
        'c_ctx': jax.random.normal(ks[3], (D_MODEL,), f32),
        'w_mod': nrm(ks[4], (DEPTH, D_MODEL, 6 * D_MODEL), D_MODEL),
        'b_mod': 0.02 * jax.random.normal(ks[5], (DEPTH, 6 * D_MODEL), f32),
        'norm1_w': gain(ks[6], (DEPTH, D_MODEL)),
        'norm2_w': gain(ks[7], (DEPTH, D_MODEL)),
        'w_in': nrm(ks[8], (DEPTH, D_MODEL, P_IN), D_MODEL),
        'gla_lr_w': nrm(ks[9], (DEPTH, 2, GLA_LOWRANK, GLA_QK), GLA_LOWRANK),
        'gla_lr_b': 0.1 * jax.random.normal(ks[10], (DEPTH, 2, GLA_QK), f32),
        'gla_norm_w': gain(ks[11], (DEPTH, GLA_HEADS, GLA_DV)),
        'gdn_conv_w': nrm(ks[12], (DEPTH, CONV_W, 2 * GDN_QK + GDN_V), CONV_W),
        'gdn_a_log': jnp.log(jax.random.uniform(ks[13], (DEPTH, 2, GDN_HEADS), f32, 1.0, 16.0)),
        'gdn_dt_bias': dt + jnp.log(-jnp.expm1(-dt)),
        'gdn_norm_w': gain(ks[15], (DEPTH, GDN_HEADS, GDN_DV)),
        'w_out': nrm(ks[16], (DEPTH, D_MODEL, D_MODEL), D_MODEL),
        'ffn_w_gate': nrm(ks[17], (DEPTH, D_MODEL, FFN_HIDDEN), D_MODEL),
        'ffn_w_up': nrm(ks[18], (DEPTH, D_MODEL, FFN_HIDDEN), D_MODEL),
        'ffn_w_down': nrm(ks[19], (DEPTH, FFN_HIDDEN, D_MODEL), FFN_HIDDEN),
        'final_norm_w': gain(ks[20], (D_MODEL,)),
    }


def reference(x, c, ctx, c_ctx, w_mod, b_mod, norm1_w, norm2_w, w_in, gla_lr_w, gla_lr_b, gla_norm_w,
              gdn_conv_w, gdn_a_log, gdn_dt_bias, gdn_norm_w, w_out, ffn_w_gate, ffn_w_up, ffn_w_down,
              final_norm_w):
    h = ctx
    for layer in range(DEPTH):
        need_ctx = layer < DEPTH - 1
        mod_l = jnp.split((jax.nn.silu(c) @ w_mod[layer] + b_mod[layer])[:, None, :], 6, axis=-1)
        mod_c = jnp.split((jax.nn.silu(c_ctx) @ w_mod[layer] + b_mod[layer])[None, None, :], 6, axis=-1)
        hn_l = modulate(rmsnorm(x, norm1_w[layer]), mod_l[0], mod_l[1])
        hn_c = modulate(rmsnorm(h, norm1_w[layer]), mod_c[0], mod_c[1])
        y_c, y_l = token_mixers(hn_c, hn_l, w_in[layer], gla_lr_w[layer], gla_lr_b[layer], gla_norm_w[layer],
                                gdn_conv_w[layer], gdn_a_log[layer], gdn_dt_bias[layer], gdn_norm_w[layer],
                                w_out[layer], need_ctx)
        x = x + mod_l[2] * y_l
        x = x + mod_l[5] * swiglu(modulate(rmsnorm(x, norm2_w[layer]), mod_l[3], mod_l[4]),
                                  ffn_w_gate[layer], ffn_w_up[layer], ffn_w_down[layer])
        if need_ctx:
            h = h + mod_c[2] * y_c
            h = h + mod_c[5] * swiglu(modulate(rmsnorm(h, norm2_w[layer]), mod_c[3], mod_c[4]),
                                      ffn_w_gate[layer], ffn_w_up[layer], ffn_w_down[layer])
    return rmsnorm(x, final_norm_w)
```

```cpp
#include <hip/hip_runtime.h>
#include <hip/hip_cooperative_groups.h>
#include <cstdio>
#include <cstdint>
namespace pg8 {
#define PG8_LAS __attribute__((address_space(3)))
typedef unsigned short bf16_t;
typedef short bf16x8 __attribute__((ext_vector_type(8)));
typedef float f32x4 __attribute__((ext_vector_type(4)));
typedef unsigned u32x4 __attribute__((ext_vector_type(4)));
constexpr int BM = 256, BK = 64, HALF = 128, HTB = HALF * BK * 2  , STAGE_BYTES = 8 * HTB, NXCD = 8, WGM = 8;

__host__ __device__ __forceinline__ int lds_byte(int r, int c) { const int st = (r >> 4) * 2 + (c >> 5), rr = r & 15, cc = c & 31, ob = rr * 64 + cc * 2; return st * 1024 + (ob ^ (((ob >> 9) & 1) << 5)); }
__host__ __device__ __forceinline__ void stage_rc(int b, int& R, int& C) { const int st = b / 1024, sb = b % 1024, swz = sb ^ (((sb >> 9) & 1) << 5); R = (st >> 1) * 16 + swz / 64; C = (st & 1) * 32 + (swz % 64) / 2; }
__host__ __device__ __forceinline__ int perm32(int rho) { const int n = rho >> 4, i = rho & 15; return 8 * (i >> 2) + 4 * n + (i & 3); }

struct Unit { int pm, pn; };
struct Gemm { const bf16_t* A; const bf16_t* Bt; int M, N, K; };

struct StaticOrder {
    int nM, nN, nwg, G, c;
    __host__ __device__ void init(int M, int N, int G_, int c_) { nM = M / BM; nN = N / BM; nwg = nM * nN; G = G_; c = c_; }
    __host__ __device__ bool next(int i, Unit& u) const {
        const long L = (long)i * G + c; if (L >= nwg) return false;
        int wgid = (int)L; { const int q = nwg / NXCD, r = nwg % NXCD, xcd = wgid % NXCD, off = wgid / NXCD; wgid = (xcd < r ? xcd * (q + 1) : r * (q + 1) + (xcd - r) * q) + off; }
        const int nig = WGM * nN, gid = wgid / nig, fm = gid * WGM, gsz = (nM - fm) < WGM ? (nM - fm) : WGM;
        u.pm = fm + ((wgid % nig) % gsz); u.pn = (wgid % nig) / gsz; return true;
    }
    __device__ __forceinline__ void a_ready(const Unit&) const {}
    __device__ __forceinline__ void done(const Unit&) const {}
};
typedef __bf16 bf16v2_t __attribute__((ext_vector_type(2)));
typedef float f32v2_t __attribute__((ext_vector_type(2)));
__device__ __forceinline__ unsigned cvt_pk_bf16(float lo, float hi) { const f32v2_t f = {lo, hi}; const bf16v2_t v = __builtin_convertvector(f, bf16v2_t); return __builtin_bit_cast(unsigned, v); }
template <class Epi, class Sched, bool STAMP = false>
__device__ __forceinline__ void gemm_phase(PG8_LAS unsigned char* lds, const Gemm g, const Sched& S, const Epi& E, unsigned long long* stamps) {
    const int tid = threadIdx.x, wid = __builtin_amdgcn_readfirstlane(tid >> 6), lane = tid & 63, wr = wid >> 2, wc = wid & 3, fr = lane & 15, fq = lane >> 4;
    const int K = g.K, nt = K / BK;
    int ts_lo = 0, ts_hi = 0, nts = 0; const unsigned long long rt_entry = STAMP ? (unsigned long long)wall_clock64() : 0ull;
#define PG8_STAMP() do { if (STAMP && wid == 0 && nts < 64) { const unsigned long long _c = (unsigned long long)clock64(); \
        ts_lo = (lane == nts) ? (int)(unsigned)_c : ts_lo; ts_hi = (lane == nts) ? (int)(unsigned)(_c >> 32) : ts_hi; ++nts; } } while (0)
    PG8_STAMP();
    unsigned voffA[2], voffB[2];
#pragma unroll
    for (int i = 0; i < 2; ++i) { int R, C; stage_rc(tid * 16 + i * 8192, R, C); const int Rb = Epi::PERM ? ((R & ~31) + perm32(R & 31)) : R;
        voffA[i] = (unsigned)(R * K + C) * 2u; voffB[i] = (unsigned)(Rb * K + C) * 2u; }
    const size_t kstep = (size_t)(BK * 2);
    const size_t hstep = (size_t)HALF * K * 2;
    const size_t tstep = 2 * hstep;
    const unsigned ldsw = (unsigned)wid * 1024u;
    const int aoff = lds_byte(wr * 64 + fr, fq * 8), boff = lds_byte(wc * 32 + fr, fq * 8);
#define PG8_SA(b, h) (((b) * 2 + (h)) * HTB)
#define PG8_SB(b, h) ((4 + (b) * 2 + (h)) * HTB)
#define PG8_STAGE(bufoff, gbase, voff) do { _Pragma("unroll") for (int _i = 0; _i < 2; ++_i) \
        __builtin_amdgcn_global_load_lds((const unsigned*)((const char*)(gbase) + (voff)[_i]), (PG8_LAS unsigned*)(lds + (bufoff) + ldsw + _i * 8192), 16, 0, 0); } while (0)
#define PG8_LDA(dst, b, h) do { _Pragma("unroll") for (int m = 0; m < 4; ++m) _Pragma("unroll") for (int k = 0; k < 2; ++k) dst[m][k] = *(const PG8_LAS bf16x8*)(lds + PG8_SA(b, h) + aoff + m * 2048 + k * 1024); } while (0)
#define PG8_LDB(dst, b, h) do { _Pragma("unroll") for (int n = 0; n < 2; ++n) _Pragma("unroll") for (int k = 0; k < 2; ++k) dst[n][k] = *(const PG8_LAS bf16x8*)(lds + PG8_SB(b, h) + boff + n * 2048 + k * 1024); } while (0)
#define PG8_MMA(ai, bj, At, Bt) do { __builtin_amdgcn_s_setprio(1); _Pragma("unroll") for (int m = 0; m < 4; ++m) _Pragma("unroll") for (int n = 0; n < 2; ++n) _Pragma("unroll") for (int k = 0; k < 2; ++k) \
        acc[ai][bj][m][n] = __builtin_amdgcn_mfma_f32_16x16x32_bf16(Bt[n][k], At[m][k], acc[ai][bj][m][n], 0, 0, 0); __builtin_amdgcn_s_setprio(0); } while (0)
#define PG8_WAIT_V(n) asm volatile("s_waitcnt vmcnt(" #n ")" ::: "memory")
#define PG8_WAIT_L(n) asm volatile("s_waitcnt lgkmcnt(" #n ")" ::: "memory")
#define PG8_BAR __builtin_amdgcn_s_barrier()
#define PG8_SCHED __builtin_amdgcn_sched_barrier(0)
    Unit cur, nxt; int ui = 0;
    if (!S.next(0, cur)) return;
    f32x4 acc[2][2][4][2];
#pragma unroll
    for (int a = 0; a < 2; ++a)
#pragma unroll
        for (int b = 0; b < 2; ++b)
#pragma unroll
            for (int m = 0; m < 4; ++m)
#pragma unroll
                for (int n = 0; n < 2; ++n) acc[a][b][m][n] = (f32x4){0.f, 0.f, 0.f, 0.f};
    bf16x8 At[4][2], B0[2][2], B1[2][2];
    const char* cA = (const char*)g.A + (size_t)cur.pm * tstep; const char* cB = (const char*)g.Bt + (size_t)cur.pn * tstep;
    S.a_ready(cur);
    PG8_STAGE(PG8_SB(0, 0), cB, voffB); PG8_STAGE(PG8_SA(0, 0), cA, voffA); PG8_STAGE(PG8_SB(0, 1), cB + hstep, voffB); PG8_STAGE(PG8_SA(0, 1), cA + hstep, voffA);
    if (wr == 1) PG8_BAR;
    PG8_WAIT_V(4); PG8_BAR;
    PG8_STAGE(PG8_SB(1, 0), cB + kstep, voffB); PG8_STAGE(PG8_SA(1, 0), cA + kstep, voffA); PG8_STAGE(PG8_SB(1, 1), cB + hstep + kstep, voffB);
    PG8_WAIT_V(6); PG8_BAR;
    PG8_STAMP();
    for (;;) {
        const bool has_next = S.next(ui + 1, nxt);
        const char* nA = has_next ? (const char*)g.A + (size_t)nxt.pm * tstep : cA; const char* nB = has_next ? (const char*)g.Bt + (size_t)nxt.pn * tstep : cB;
        for (int t = 0; t < nt; t += 2) {
            const bool last = (t == nt - 2);
            const char* a1 = cA + (size_t)(t + 1) * kstep;
            const char* a2 = last ? nA : cA + (size_t)(t + 2) * kstep; const char* b2 = last ? nB : cB + (size_t)(t + 2) * kstep;
            const char* a3 = a2 + kstep; const char* b3 = b2 + kstep;
            if (last && has_next) S.a_ready(nxt);
            PG8_LDB(B0, 0, 0); PG8_SCHED; PG8_LDA(At, 0, 0); PG8_STAGE(PG8_SA(1, 1), a1 + hstep, voffA);
            PG8_WAIT_L(8); PG8_BAR; PG8_WAIT_L(0); PG8_MMA(0, 0, At, B0); PG8_BAR; PG8_SCHED;
            PG8_LDB(B1, 0, 1); PG8_STAGE(PG8_SB(0, 0), b2, voffB);
            PG8_BAR; PG8_WAIT_L(0); PG8_MMA(0, 1, At, B1); PG8_BAR;
            PG8_LDA(At, 0, 1); PG8_STAGE(PG8_SA(0, 0), a2, voffA);
            PG8_BAR; PG8_WAIT_L(0); PG8_MMA(1, 0, At, B0); PG8_BAR; PG8_SCHED;
            PG8_STAGE(PG8_SB(0, 1), b2 + hstep, voffB);
            PG8_WAIT_V(6); PG8_BAR; PG8_MMA(1, 1, At, B1); PG8_BAR;
            PG8_LDB(B0, 1, 0); PG8_SCHED; PG8_LDA(At, 1, 0); PG8_STAGE(PG8_SA(0, 1), a2 + hstep, voffA);
            PG8_WAIT_L(8); PG8_BAR; PG8_WAIT_L(0); PG8_MMA(0, 0, At, B0); PG8_BAR; PG8_SCHED;
            PG8_LDB(B1, 1, 1); PG8_STAGE(PG8_SB(1, 0), b3, voffB);
            PG8_BAR; PG8_WAIT_L(0); PG8_MMA(0, 1, At, B1); PG8_BAR;
            PG8_LDA(At, 1, 1); PG8_STAGE(PG8_SA(1, 0), a3, voffA);
            PG8_BAR; PG8_WAIT_L(0); PG8_MMA(1, 0, At, B0); PG8_BAR; PG8_SCHED;
            PG8_STAGE(PG8_SB(1, 1), b3 + hstep, voffB);
            PG8_WAIT_V(6); PG8_BAR; PG8_MMA(1, 1, At, B1); PG8_BAR;
        }
        PG8_STAMP();
        if constexpr (!Epi::AFTER_DRAIN) { E(acc, cur, wr, wc, fr, fq); S.done(cur); }
        PG8_STAMP();
        if (!has_next) break;
#pragma unroll
        for (int a = 0; a < 2; ++a)
#pragma unroll
            for (int b = 0; b < 2; ++b)
#pragma unroll
                for (int m = 0; m < 4; ++m)
#pragma unroll
                    for (int n = 0; n < 2; ++n) acc[a][b][m][n] = (f32x4){0.f, 0.f, 0.f, 0.f};
        cur = nxt; cA = nA; cB = nB; ++ui;
    }
    PG8_WAIT_V(0);
    if (wr == 0) PG8_BAR;
    PG8_BAR;
    if constexpr (Epi::AFTER_DRAIN) { E.fused(acc, cur, wr, wc, fr, fq, lds, wid, lane); S.done(cur); }
    PG8_STAMP();
    if (STAMP && wid == 0) { stamps[lane] = lane < nts ? (((unsigned long long)(unsigned)ts_hi << 32) | (unsigned)ts_lo) : 0ull;
        if (lane == 62) stamps[62] = rt_entry; if (lane == 63) stamps[63] = (unsigned long long)wall_clock64(); }
#undef PG8_STAMP
#undef PG8_SA
#undef PG8_SB
#undef PG8_STAGE
#undef PG8_LDA
#undef PG8_LDB
#undef PG8_MMA
#undef PG8_WAIT_V
#undef PG8_WAIT_L
#undef PG8_BAR
#undef PG8_SCHED
}
}

namespace cg = cooperative_groups;
using pg8::bf16_t; using pg8::bf16x8; using pg8::f32x4; using pg8::u32x4;
typedef short s16x4 __attribute__((ext_vector_type(4)));
typedef unsigned u32x2 __attribute__((ext_vector_type(2)));
typedef float f32x2 __attribute__((ext_vector_type(2)));
#define LAS __attribute__((address_space(3)))
#define DI __device__ __forceinline__

#ifndef N_LAUNCHES
#define N_LAUNCHES 12
#endif

constexpr int DM = 1024, NB = 8, SEQ = 8192, CTXL = 256;
constexpr int ML = NB * SEQ, MC = NB * CTXL, MALL = ML + MC;
constexpr int NSCAN = 5184, NSCAN_PAD = 5376, NMERGE = 4096, FFN = 2816, NGU = 5632;
constexpr int NCHUNK = 132, NPHASE = 12;
constexpr float EPSF = 1e-6f, LOG2E = 1.4426950408889634f, LN2 = 0.6931471805599453f;

constexpr size_t OFF_WSCAN = 0;
constexpr size_t OFF_WMERGE = OFF_WSCAN + (size_t)NSCAN_PAD * DM * 2;
constexpr size_t OFF_WOUT = OFF_WMERGE + (size_t)NMERGE * DM * 2;
constexpr size_t OFF_WGU = OFF_WOUT + (size_t)DM * DM * 2;
constexpr size_t OFF_WD = OFF_WGU + (size_t)NGU * DM * 2;
constexpr size_t OFF_MOD = OFF_WD + (size_t)DM * FFN * 2;
constexpr size_t OFF_SS = OFF_MOD + 221184;
constexpr size_t OFF_HN = OFF_SS + (size_t)ML * 32 * 4;
constexpr size_t OFF_TINV = OFF_HN + (size_t)MALL * DM * 2;
constexpr size_t OFF_PSCAN = OFF_TINV + (size_t)NCHUNK * NB * 8 * 2 * 4096 * 2;
constexpr size_t WS_END = OFF_PSCAN + (size_t)MALL * NSCAN * 2;
constexpr size_t OFF_M = OFF_PSCAN;
constexpr size_t OFF_H = OFF_PSCAN;
constexpr size_t OFF_X1 = OFF_PSCAN + (size_t)ML * FFN * 2;
static_assert(OFF_X1 + (size_t)ML * DM * 4 <= WS_END, "overlay");
static_assert(WS_END <= (size_t)1073741824, "workspace");
constexpr int LDS_BYTES = 147456;

struct Params {
    const float *x, *c, *ctx, *c_ctx, *w_mod, *b_mod, *norm1_w, *norm2_w, *w_in, *gla_lr_w, *gla_lr_b, *gla_norm_w, *gdn_conv_w, *gdn_a_log,
        *gdn_dt_bias, *gdn_norm_w, *w_out, *ffn_w_gate, *ffn_w_up, *ffn_w_down, *final_norm_w;
    float* out; unsigned char* ws; int ph_lo, ph_hi;
};

DI float wave_sum(float v) {
#pragma unroll
    for (int o = 1; o < 64; o <<= 1) v += __shfl_xor(v, o);
    return v;
}
DI unsigned pk2(float lo, float hi) { return pg8::cvt_pk_bf16(lo, hi); }
DI float bflo(unsigned w) { return __uint_as_float(w << 16); }
DI float bfhi(unsigned w) { return __uint_as_float(w & 0xffff0000u); }
DI float bf2f(bf16_t v) { return __uint_as_float(((unsigned)v) << 16); }
DI bf16_t f2bf(float f) { return (bf16_t)(pk2(f, 0.f) & 0xffffu); }
DI float ex2(float x) { return __builtin_amdgcn_exp2f(x); }
DI float lg2(float x) { return __builtin_amdgcn_logf(x); }
DI float rcpf_(float x) { return __builtin_amdgcn_rcpf(x); }
DI float sigm(float x) { return rcpf_(1.f + ex2(-LOG2E * x)); }
DI float silu_(float x) { return x * sigm(x); }
DI float softplus_(float x) {
    const float t = ex2(-LOG2E * fabsf(x));
    const float l = t < 0.01f ? t * (1.f - t * (0.5f - t * 0.33333333f)) : LN2 * lg2(1.f + t);
    return fmaxf(x, 0.f) + l;
}
DI f32x4 mfma16(bf16x8 a, bf16x8 b, f32x4 c) { return __builtin_amdgcn_mfma_f32_16x16x32_bf16(a, b, c, 0, 0, 0); }
DI bf16x8 ldsRow(LAS const unsigned char* p) { return *(LAS const bf16x8*)p; }
DI bf16x8 ldsT(LAS const unsigned char* img, int pitch, int k0, int m0, int lane) {
    const int g = lane >> 4, i16 = lane & 15;
    LAS const unsigned char* a = img + (k0 + 8 * g + (i16 >> 2)) * pitch + 2 * m0 + 8 * (i16 & 3);
    const s16x4 lo = __builtin_amdgcn_ds_read_tr16_b64_v4i16((LAS s16x4*)a);
    const s16x4 hi = __builtin_amdgcn_ds_read_tr16_b64_v4i16((LAS s16x4*)(a + 4 * pitch));
    return __builtin_shufflevector(lo, hi, 0, 1, 2, 3, 4, 5, 6, 7);
}
DI u32x2 pack4(f32x4 v) { u32x2 o; o.x = pk2(v[0], v[1]); o.y = pk2(v[2], v[3]); return o; }
DI void lds_wait() { asm volatile("s_waitcnt lgkmcnt(0)" ::: "memory"); }

DI void tr_item(const float* W, int ldw, int srccol, int k0, bf16_t* dst, int K, LAS float* scr, int lane) {
#pragma unroll 8
    for (int i = 0; i < 32; ++i) { const int kk = 2 * i + (lane >> 5); scr[kk * 33 + (lane & 31)] = srccol >= 0 ? W[(size_t)(k0 + kk) * ldw + srccol] : 0.f; }
    lds_wait();
    const int c = lane & 7;
#pragma unroll
    for (int j = 0; j < 4; ++j) { const int n = (lane >> 3) + 8 * j; LAS const float* s = scr + (8 * c) * 33 + n;
        u32x4 o; o.x = pk2(s[0], s[33]); o.y = pk2(s[66], s[99]); o.z = pk2(s[132], s[165]); o.w = pk2(s[198], s[231]);
        *(u32x4*)(dst + (size_t)n * K + 8 * c) = o; }
    lds_wait();
}
DI int src_scan(int n) { return n < 2048 ? n : (n < 5120 ? 3104 + (n - 2048) : (n < 5152 ? 3072 + (n - 5120) : (n < 5184 ? 7200 + (n - 5152) : -1))); }
DI int src_merge(int n) {
    const int pn = n >> 8, ct = n & 255, bj = ct >> 7, wc = (ct >> 5) & 3, nn = (ct >> 4) & 1, r = ct & 15, ch = 64 * pn + 16 * wc + r;
    const int base = bj == 0 ? (nn == 0 ? 2048 : 7232) : (nn == 0 ? 6176 : 8256);
    return base + ch;
}
DI void phase0(const Params& p, LAS unsigned char* lds) {
    const int tid = threadIdx.x, wave = tid >> 6, lane = tid & 63;
    const int gw = blockIdx.x * 8 + wave, NGW = gridDim.x * 8;
    LAS float* scr = (LAS float*)(lds + wave * 8448);
    bf16_t* Wscan = (bf16_t*)(p.ws + OFF_WSCAN); bf16_t* Wmerge = (bf16_t*)(p.ws + OFF_WMERGE); bf16_t* Wout = (bf16_t*)(p.ws + OFF_WOUT);
    bf16_t* Wgu = (bf16_t*)(p.ws + OFF_WGU); bf16_t* Wd = (bf16_t*)(p.ws + OFF_WD);
    constexpr int I_SCAN = 16 * (NSCAN_PAD / 32), I_MERGE = 16 * (NMERGE / 32), I_OUT = 16 * 32, I_GU = 16 * (NGU / 32), I_D = (FFN / 64) * 32;
    constexpr int NITEMS = I_SCAN + I_MERGE + I_OUT + I_GU + I_D;
    {
        LAS float* st = (LAS float*)(lds + 8 * 8448);
        for (int idx = tid; idx < 9 * 1024; idx += 512) { const int b = idx >> 10, k = idx & 1023; st[idx] = silu_(b < 8 ? p.c[b * DM + k] : p.c_ctx[k]); }
        __syncthreads();
    }
    for (int it = gw; it < NITEMS; it += NGW) {
        int r = it;
        if (r < I_SCAN) { const int nblk = NSCAN_PAD / 32, kb = r / nblk, nb = r % nblk, n0 = 32 * nb;
            tr_item(p.w_in, 9280, src_scan(n0 + (lane & 31)), 64 * kb, Wscan + (size_t)n0 * DM + 64 * kb, DM, scr, lane); continue; }
        r -= I_SCAN;
        if (r < I_MERGE) { const int nblk = NMERGE / 32, kb = r / nblk, nb = r % nblk, n0 = 32 * nb;
            tr_item(p.w_in, 9280, src_merge(n0 + (lane & 31)), 64 * kb, Wmerge + (size_t)n0 * DM + 64 * kb, DM, scr, lane); continue; }
        r -= I_MERGE;
        if (r < I_OUT) { const int nblk = 32, kb = r / nblk, nb = r % nblk, n0 = 32 * nb;
            tr_item(p.w_out, DM, n0 + (lane & 31), 64 * kb, Wout + (size_t)n0 * DM + 64 * kb, DM, scr, lane); continue; }
        r -= I_OUT;
        if (r < I_GU) { const int nblk = NGU / 32, kb = r / nblk, nb = r % nblk, n0 = 32 * nb;
            const int pn = n0 >> 8, ct = n0 & 255; const float* W = ct < 128 ? p.ffn_w_gate : p.ffn_w_up; const int c0 = 128 * pn + (ct & 127);
            tr_item(W, FFN, c0 + (lane & 31), 64 * kb, Wgu + (size_t)n0 * DM + 64 * kb, DM, scr, lane); continue; }
        r -= I_GU;
        { const int nblk = 32, kb = r / nblk, nb = r % nblk, n0 = 32 * nb;
            tr_item(p.ffn_w_down, DM, n0 + (lane & 31), 64 * kb, Wd + (size_t)n0 * FFN + 64 * kb, FFN, scr, lane); }
    }
    float* mod = (float*)(p.ws + OFF_MOD);
    LAS const float* stab = (LAS const float*)(lds + 8 * 8448);
    for (int it = gw; it < 384; it += NGW) {
        const int col = it * 16 + (lane & 15), kq = lane >> 4;
        float acc[9];
#pragma unroll
        for (int b = 0; b < 9; ++b) acc[b] = 0.f;
#pragma unroll 8
        for (int kk = 0; kk < 256; ++kk) {
            const int k = 256 * kq + kk;
            const float w = p.w_mod[(size_t)k * 6144 + col];
#pragma unroll
            for (int b = 0; b < 9; ++b) acc[b] += stab[b * 1024 + k] * w;
        }
#pragma unroll
        for (int b = 0; b < 9; ++b) { acc[b] += __shfl_xor(acc[b], 16); acc[b] += __shfl_xor(acc[b], 32); }
        if (kq == 0) { const float bias = p.b_mod[col];
#pragma unroll
            for (int b = 0; b < 9; ++b) mod[b * 6144 + col] = acc[b] + bias; }
    }
}

DI void norm_mod_row(const float* xr, bf16_t* orow, const float* nw, const float* shift, const float* scale, int lane) {
    f32x4 v[4]; float s = 0.f;
#pragma unroll
    for (int j = 0; j < 4; ++j) { v[j] = *(const f32x4*)(xr + 4 * lane + 256 * j); s += (v[j][0] * v[j][0] + v[j][1] * v[j][1]) + (v[j][2] * v[j][2] + v[j][3] * v[j][3]); }
    const float rstd = rsqrtf(wave_sum(s) * (1.f / DM) + EPSF);
#pragma unroll
    for (int j = 0; j < 4; ++j) {
        const int cidx = 4 * lane + 256 * j;
        const f32x4 w = *(const f32x4*)(nw + cidx), sh = *(const f32x4*)(shift + cidx), sc = *(const f32x4*)(scale + cidx);
        f32x4 y;
#pragma unroll
        for (int e = 0; e < 4; ++e) y[e] = (v[j][e] * rstd * w[e]) * (1.f + sc[e]) + sh[e];
        *(u32x2*)(orow + cidx) = pack4(y);
    }
}
DI void phase_hn(const Params& p) {
    const int wave = threadIdx.x >> 6, lane = threadIdx.x & 63, gw = blockIdx.x * 8 + wave, NGW = gridDim.x * 8;
    const float* mod = (const float*)(p.ws + OFF_MOD); bf16_t* hn = (bf16_t*)(p.ws + OFF_HN);
    for (int r = gw; r < MALL; r += NGW) {
        const float* xr = r < ML ? p.x + (size_t)r * DM : p.ctx + (size_t)(r - ML) * DM;
        const int mb = r < ML ? r / SEQ : 8;
        norm_mod_row(xr, hn + (size_t)r * DM, p.norm1_w, mod + mb * 6144, mod + mb * 6144 + 1024, lane);
    }
}
DI void phase_hn2(const Params& p) {
    const int wave = threadIdx.x >> 6, lane = threadIdx.x & 63, gw = blockIdx.x * 8 + wave, NGW = gridDim.x * 8;
    const float* mod = (const float*)(p.ws + OFF_MOD); bf16_t* hn = (bf16_t*)(p.ws + OFF_HN); const float* x1 = (const float*)(p.ws + OFF_X1);
    for (int r = gw; r < ML; r += NGW) {
        const int mb = r / SEQ;
        norm_mod_row(x1 + (size_t)r * DM, hn + (size_t)r * DM, p.norm2_w, mod + mb * 6144 + 3072, mod + mb * 6144 + 4096, lane);
    }
}
DI void phase_final(const Params& p) {
    const int wave = threadIdx.x >> 6, lane = threadIdx.x & 63, gw = blockIdx.x * 8 + wave, NGW = gridDim.x * 8;
    for (int r = gw; r < ML; r += NGW) {
        float* xr = p.out + (size_t)r * DM;
        f32x4 v[4]; float s = 0.f;
#pragma unroll
        for (int j = 0; j < 4; ++j) { v[j] = *(const f32x4*)(xr + 4 * lane + 256 * j); s += (v[j][0] * v[j][0] + v[j][1] * v[j][1]) + (v[j][2] * v[j][2] + v[j][3] * v[j][3]); }
        const float rstd = rsqrtf(wave_sum(s) * (1.f / DM) + EPSF);
#pragma unroll
        for (int j = 0; j < 4; ++j) { const f32x4 w = *(const f32x4*)(p.final_norm_w + 4 * lane + 256 * j); f32x4 y;
#pragma unroll
            for (int e = 0; e < 4; ++e) y[e] = v[j][e] * rstd * w[e];
            *(f32x4*)(xr + 4 * lane + 256 * j) = y; }
    }
}

struct EpiScan {
    static constexpr bool PERM = true, AFTER_DRAIN = false;
    bf16_t* O;
    __device__ __forceinline__ void operator()(const f32x4 (&acc)[2][2][4][2], const pg8::Unit& u, int wr, int wc, int fr, int fq) const {
        const int row0 = u.pm * 256 + wr * 64 + fr, colt = u.pn * 256 + wc * 32 + 8 * fq;
#pragma unroll
        for (int ai = 0; ai < 2; ++ai)
#pragma unroll
            for (int m = 0; m < 4; ++m) { bf16_t* rowp = O + (size_t)(row0 + ai * 128 + m * 16) * NSCAN + colt;
#pragma unroll
                for (int bj = 0; bj < 2; ++bj) if (colt + bj * 128 < NSCAN) {
                    const f32x4 v0 = acc[ai][bj][m][0], v1 = acc[ai][bj][m][1];
                    u32x4 w; w.x = pk2(v0[0], v0[1]); w.y = pk2(v0[2], v0[3]); w.z = pk2(v1[0], v1[1]); w.w = pk2(v1[2], v1[3]);
                    *(u32x4*)(rowp + bj * 128) = w; } }
    }
};
struct EpiMerge {
    static constexpr bool PERM = false, AFTER_DRAIN = false;
    const bf16_t* O; const float* ss; const float* gw_gla; const float* gw_gdn; bf16_t* Mo;
    __device__ __forceinline__ void operator()(const f32x4 (&acc)[2][2][4][2], const pg8::Unit& u, int wr, int wc, int fr, int fq) const {
        const int ch = u.pn * 64 + wc * 16 + 4 * fq, hg = ch >> 8, hd = ch >> 7;
        const f32x4 gg = *(const f32x4*)(gw_gla + ch), gd = *(const f32x4*)(gw_gdn + ch);
#pragma unroll
        for (int ai = 0; ai < 2; ++ai)
#pragma unroll
            for (int m = 0; m < 4; ++m) {
                const int row = u.pm * 256 + ai * 128 + wr * 64 + m * 16 + fr;
                const u32x2 og = *(const u32x2*)(O + (size_t)row * 2048 + ch), od = *(const u32x2*)(O + (size_t)row * 2048 + 1024 + ch);
                const float* sg = ss + (size_t)(4 * hg) * ML + row; const float* sd = ss + (size_t)(16 + 2 * hd) * ML + row;
                const float rg = rsqrtf(((sg[0] + sg[ML]) + (sg[2 * (size_t)ML] + sg[3 * (size_t)ML])) * (1.f / 256.f) + EPSF), rd = rsqrtf((sd[0] + sd[ML]) * (1.f / 128.f) + EPSF);
                const float ogf[4] = {bflo(og.x), bfhi(og.x), bflo(og.y), bfhi(og.y)}, odf[4] = {bflo(od.x), bfhi(od.x), bflo(od.y), bfhi(od.y)};
                f32x4 mv;
#pragma unroll
                for (int j = 0; j < 4; ++j) {
                    const float zg = acc[ai][0][m][0][j], ggv = acc[ai][0][m][1][j], zd = acc[ai][1][m][0][j], gdv = acc[ai][1][m][1][j];
                    const float yg = ogf[j] * rg * gg[j] * silu_(zg), yd = odf[j] * rd * gd[j] * silu_(zd);
                    mv[j] = sigm(ggv) * yg + sigm(gdv) * yd;
                }
                *(u32x2*)(Mo + (size_t)row * DM + ch) = pack4(mv);
            }
    }
};
struct EpiRes {
    static constexpr bool PERM = false, AFTER_DRAIN = false;
    const float* base; const float* gate; float* Out;
    __device__ __forceinline__ void operator()(const f32x4 (&acc)[2][2][4][2], const pg8::Unit& u, int wr, int wc, int fr, int fq) const {
        const int row0 = u.pm * 256 + wr * 64 + fr, col0 = u.pn * 256 + wc * 32 + 4 * fq, b = u.pm >> 5;
        f32x4 gv[2][2];
#pragma unroll
        for (int bj = 0; bj < 2; ++bj)
#pragma unroll
            for (int n = 0; n < 2; ++n) gv[bj][n] = *(const f32x4*)(gate + b * 6144 + col0 + bj * 128 + n * 16);
#pragma unroll
        for (int ai = 0; ai < 2; ++ai)
#pragma unroll
            for (int m = 0; m < 4; ++m) { const size_t ro = (size_t)(row0 + ai * 128 + m * 16) * DM + col0;
#pragma unroll
                for (int bj = 0; bj < 2; ++bj)
#pragma unroll
                    for (int n = 0; n < 2; ++n) { const f32x4 bv = *(const f32x4*)(base + ro + bj * 128 + n * 16);
                        *(f32x4*)(Out + ro + bj * 128 + n * 16) = bv + gv[bj][n] * acc[ai][bj][m][n]; } }
    }
};
struct EpiGU {
    static constexpr bool PERM = true, AFTER_DRAIN = false;
    bf16_t* H;
    __device__ __forceinline__ void operator()(const f32x4 (&acc)[2][2][4][2], const pg8::Unit& u, int wr, int wc, int fr, int fq) const {
        const int row0 = u.pm * 256 + wr * 64 + fr, col0 = u.pn * 128 + wc * 32 + 8 * fq;
#pragma unroll
        for (int ai = 0; ai < 2; ++ai)
#pragma unroll
            for (int m = 0; m < 4; ++m) {
                f32x4 h0, h1;
#pragma unroll
                for (int j = 0; j < 4; ++j) { h0[j] = silu_(acc[ai][0][m][0][j]) * acc[ai][1][m][0][j]; h1[j] = silu_(acc[ai][0][m][1][j]) * acc[ai][1][m][1][j]; }
                u32x4 w; w.x = pk2(h0[0], h0[1]); w.y = pk2(h0[2], h0[3]); w.z = pk2(h1[0], h1[1]); w.w = pk2(h1[2], h1[3]);
                *(u32x4*)(H + (size_t)(row0 + ai * 128 + m * 16) * FFN + col0) = w; }
    }
};

template <int RPL>
DI void conv_tile(bf16_t* P, size_t row0, size_t rstride, int slice, const float* conv_w, int wave, int lane) {
    constexpr int NR = 32 * RPL;
    const int rq = lane >> 4, cl = lane & 15, rbase = (wave * 4 + rq) * RPL, ch = slice * 128 + cl * 8;
    bf16_t* colp = P + 2048 + ch;
    u32x4 in[RPL + 4];
#pragma unroll
    for (int t = 0; t < RPL + 4; ++t) { const int r = rbase + t - 2;
        in[t] = (r >= 0 && r < NR) ? *(const u32x4*)(colp + (row0 + (size_t)r * rstride) * NSCAN) : (u32x4){0u, 0u, 0u, 0u}; }
    float w[5][8];
#pragma unroll
    for (int i = 0; i < 5; ++i) { const f32x4 a = *(const f32x4*)(conv_w + i * 3072 + ch), b = *(const f32x4*)(conv_w + i * 3072 + ch + 4);
#pragma unroll
        for (int e = 0; e < 4; ++e) { w[i][e] = a[e]; w[i][4 + e] = b[e]; } }
    asm volatile("s_waitcnt vmcnt(0)" ::: "memory");
    __syncthreads();
#pragma unroll
    for (int t = 0; t < RPL; ++t) {
        float acc[8];
#pragma unroll
        for (int e = 0; e < 8; ++e) acc[e] = 0.f;
#pragma unroll
        for (int i = 0; i < 5; ++i) { const u32x4 v = in[t + i];
            acc[0] += w[i][0] * bflo(v.x); acc[1] += w[i][1] * bfhi(v.x); acc[2] += w[i][2] * bflo(v.y); acc[3] += w[i][3] * bfhi(v.y);
            acc[4] += w[i][4] * bflo(v.z); acc[5] += w[i][5] * bfhi(v.z); acc[6] += w[i][6] * bflo(v.w); acc[7] += w[i][7] * bfhi(v.w); }
        float ssq = 0.f;
#pragma unroll
        for (int e = 0; e < 8; ++e) { acc[e] = silu_(acc[e]); ssq += acc[e] * acc[e]; }
        if (slice < 16) {
            ssq += __shfl_xor(ssq, 1); ssq += __shfl_xor(ssq, 2); ssq += __shfl_xor(ssq, 4); ssq += __shfl_xor(ssq, 8);
            const float sc = rsqrtf(ssq + EPSF) * (slice < 8 ? 0.08838834764831845f : 1.f);
#pragma unroll
            for (int e = 0; e < 8; ++e) acc[e] *= sc;
        }
        u32x4 o; o.x = pk2(acc[0], acc[1]); o.y = pk2(acc[2], acc[3]); o.z = pk2(acc[4], acc[5]); o.w = pk2(acc[6], acc[7]);
        *(u32x4*)(colp + (row0 + (size_t)(rbase + t) * rstride) * NSCAN) = o;
    }
}
DI void phase_conv(const Params& p) {
    const int wave = threadIdx.x >> 6, lane = threadIdx.x & 63;
    bf16_t* P = (bf16_t*)(p.ws + OFF_PSCAN);
    constexpr int NLAT = NB * 64 * 24, NCT = NB * 24;
    for (int T = blockIdx.x; T < NLAT + NCT; T += gridDim.x) {
        if (T < NLAT) { const int slice = T % 24, col = (T / 24) % 64, b = T / (24 * 64);
            conv_tile<4>(P, (size_t)b * SEQ + col, 64, slice, p.gdn_conv_w, wave, lane); }
        else { const int T2 = T - NLAT, slice = T2 % 24, b = T2 / 24;
            conv_tile<8>(P, (size_t)ML + (size_t)b * CTXL, 1, slice, p.gdn_conv_w, wave, lane); }
    }
}

template <int DIR> DI int chunk_id(int st) { return DIR == 0 ? st : (st < 4 ? 3 - st : 135 - st); }
DI int gla_base(int b, int cid) { return cid < 4 ? ML + b * CTXL + 64 * cid : b * SEQ + 64 * (cid - 4); }
DI int gdn_row(int b, int cid, int i) {
    if (cid < 4) return ML + b * CTXL + 64 * cid + i;
    const int cl = cid - 4; return b * SEQ + (((cl & 1) * 64 + i) * 64) + (cl >> 1);
}
DI float wave_prefix(float v, int lane) {
#pragma unroll
    for (int o = 1; o < 64; o <<= 1) { const float t = __shfl_up(v, o); if (lane >= o) v += t; }
    return v;
}
DI void gdn_gates(const Params& p, int dir, int h, float a, float bb, float& g2, float& beta) {
    const float A = __expf(p.gdn_a_log[dir * 8 + h]);
    g2 = -A * softplus_(a + p.gdn_dt_bias[dir * 8 + h]) * LOG2E;
    beta = sigm(bb);
}

template <int I> struct SolveRows {
    static DI void run(float (&x)[64], LAS const float* Lm, int lane) {
        float a = (lane == I) ? 1.f : 0.f;
#pragma unroll
        for (int m4 = 0; m4 < (I + 3) / 4; ++m4) {
            const f32x4 l = *(LAS const f32x4*)(Lm + I * 64 + 4 * m4);
            if (4 * m4 + 0 < I) a -= l[0] * x[4 * m4 + 0];
            if (4 * m4 + 1 < I) a -= l[1] * x[4 * m4 + 1];
            if (4 * m4 + 2 < I) a -= l[2] * x[4 * m4 + 2];
            if (4 * m4 + 3 < I) a -= l[3] * x[4 * m4 + 3];
        }
        x[I] = a;
        asm volatile("" ::: "memory");
        SolveRows<I + 1>::run(x, Lm, lane);
    }
};
template <> struct SolveRows<64> { static DI void run(float (&)[64], LAS const float*, int) {} };

DI void phase_tinv(const Params& p, LAS unsigned char* lds) {
    const int tid = threadIdx.x, wave = tid >> 6, lane = tid & 63, r = lane & 15, q = lane >> 4;
    const int gw = blockIdx.x * 8 + wave, NGW = gridDim.x * 8;
    LAS unsigned char* kt = lds + wave * 18432; LAS float* Lm = (LAS float*)kt; LAS float* sc = (LAS float*)(kt + 17408);
    const bf16_t* P = (const bf16_t*)(p.ws + OFF_PSCAN); bf16_t* TI = (bf16_t*)(p.ws + OFF_TINV);
#pragma unroll 1
    for (int it = gw; it < NB * NCHUNK * 16; it += NGW) {
        const int dir = it & 1, h = (it >> 1) & 7, cid = (it >> 4) % NCHUNK, b = it / (16 * NCHUNK);
#pragma unroll
        for (int t = 0; t < 16; ++t) { const int i = q + 4 * t, c16 = r;
            const u32x4 v = *(const u32x4*)(P + (size_t)gdn_row(b, cid, i) * NSCAN + 3072 + 128 * h + 8 * c16);
            *(LAS u32x4*)(kt + q * 272 + 16 * c16 + t * (4 * 272)) = v; }
        {
            const bf16_t* rp = P + (size_t)gdn_row(b, cid, lane) * NSCAN + 5152 + 8 * dir + h;
            float g2, be;
            gdn_gates(p, dir, h, bf2f(rp[0]), bf2f(rp[16]), g2, be);
            const float Pf = wave_prefix(g2, lane), Tall = __shfl(Pf, 63);
            sc[lane] = dir == 0 ? Pf : Tall - Pf + g2; sc[64 + lane] = be;
        }
        lds_wait();
        f32x4 kk[4][4];
#pragma unroll
        for (int a = 0; a < 4; ++a)
#pragma unroll
            for (int c = 0; c < 4; ++c) kk[a][c] = (f32x4){0.f, 0.f, 0.f, 0.f};
#pragma unroll
        for (int ks = 0; ks < 4; ++ks) { bf16x8 fr[4];
#pragma unroll
            for (int t = 0; t < 4; ++t) fr[t] = ldsRow(kt + (16 * t + r) * 272 + 64 * ks + 16 * q);
#pragma unroll
            for (int a = 0; a < 4; ++a)
#pragma unroll
                for (int c = 0; c < 4; ++c) kk[a][c] = mfma16(fr[a], fr[c], kk[a][c]); }
        {
            float Gj[4], Bj[4];
#pragma unroll
            for (int c = 0; c < 4; ++c) { Gj[c] = sc[16 * c + r]; Bj[c] = sc[64 + 16 * c + r]; }
            LAS float* lrow = Lm + (4 * q) * 64 + r;
#pragma unroll
            for (int a = 0; a < 4; ++a) { const f32x4 g4 = *(LAS const f32x4*)(sc + 16 * a + 4 * q), b4 = *(LAS const f32x4*)(sc + 64 + 16 * a + 4 * q);
#pragma unroll
                for (int c = 0; c < 4; ++c)
#pragma unroll
                    for (int e = 0; e < 4; ++e) {
                        const int i = 16 * a + 4 * q + e, j = 16 * c + r;
                        const float dg = dir == 0 ? g4[e] - Gj[c] : Gj[c] - g4[e], be = dir == 0 ? b4[e] : Bj[c];
                        const float val = (j < i) ? be * kk[a][c][e] * ex2(fminf(dg, 0.f)) : 0.f;
                        lrow[(16 * a + e) * 64 + 16 * c] = val;
                    } }
        }
        lds_wait();
        float x[64];
        SolveRows<0>::run(x, Lm, lane);
        lds_wait();
        LAS bf16_t* img = (LAS bf16_t*)kt;
        if (dir == 0) {
#pragma unroll
            for (int i = 0; i < 64; ++i) img[i * 64 + lane] = f2bf(x[i]);
        } else {
#pragma unroll
            for (int i = 0; i < 64; ++i) img[lane * 64 + i] = f2bf(x[i]);
        }
        lds_wait();
        bf16_t* dst = TI + ((size_t)(((b * NCHUNK + cid) * 8 + h) * 2 + dir)) * 4096;
#pragma unroll
        for (int t = 0; t < 8; ++t) { const int pcs = lane + 64 * t; *(u32x4*)(dst + pcs * 8) = *(LAS const u32x4*)(kt + pcs * 16); }
        lds_wait();
    }
}

constexpr int L_Q = 0, L_K = 17408, L_V = 34816, L_A = 44032, L_SB = 53248, L_X = 71680  , L_R = 80896, L_VN = 90112, L_VD = 99328,
              L_SC = 108544  , L_SSP = 109824;

struct Pre { u32x4 q0, q1, k0, k1, v, x; unsigned pa, pb; };

template <int DIR> DI void gla_prefetch(const Params& p, int b, int h, int s, int st, Pre& R) {
    const int tid = threadIdx.x, cid = chunk_id<DIR>(st);
    const bf16_t* P = (const bf16_t*)(p.ws + OFF_PSCAN) + (size_t)gla_base(b, cid) * NSCAN;
    const int i = tid >> 4, c16 = tid & 15;
    R.q0 = *(const u32x4*)(P + (size_t)i * NSCAN + 128 * h + 8 * c16); R.q1 = *(const u32x4*)(P + (size_t)(i + 32) * NSCAN + 128 * h + 8 * c16);
    R.k0 = *(const u32x4*)(P + (size_t)i * NSCAN + 512 + 128 * h + 8 * c16); R.k1 = *(const u32x4*)(P + (size_t)(i + 32) * NSCAN + 512 + 128 * h + 8 * c16);
    R.v = *(const u32x4*)(P + (size_t)(tid >> 3) * NSCAN + 1024 + 256 * h + 64 * s + 8 * (tid & 7));
    if (tid < 128) R.x = *(const u32x4*)(P + (size_t)(tid >> 1) * NSCAN + 5120 + 16 * DIR + 8 * (tid & 1));
}
template <int DIR> DI void gdn_prefetch(const Params& p, int b, int h, int s, int st, Pre& R) {
    const int tid = threadIdx.x, cid = chunk_id<DIR>(st);
    const bf16_t* P = (const bf16_t*)(p.ws + OFF_PSCAN);
    const int i = tid >> 4, c16 = tid & 15;
    const size_t r0 = (size_t)gdn_row(b, cid, i) * NSCAN, r1 = (size_t)gdn_row(b, cid, i + 32) * NSCAN;
    R.q0 = *(const u32x4*)(P + r0 + 2048 + 128 * h + 8 * c16); R.q1 = *(const u32x4*)(P + r1 + 2048 + 128 * h + 8 * c16);
    R.k0 = *(const u32x4*)(P + r0 + 3072 + 128 * h + 8 * c16); R.k1 = *(const u32x4*)(P + r1 + 3072 + 128 * h + 8 * c16);
    R.v = *(const u32x4*)(P + (size_t)gdn_row(b, cid, tid >> 3) * NSCAN + 4096 + 128 * h + 64 * s + 8 * (tid & 7));
    const bf16_t* TI = (const bf16_t*)(p.ws + OFF_TINV) + ((size_t)(((b * NCHUNK + cid) * 8 + h) * 2 + DIR)) * 4096;
    R.x = *(const u32x4*)(TI + tid * 8);
    if (tid < 64) { const bf16_t* rp = P + (size_t)gdn_row(b, cid, tid) * NSCAN + 5152 + 8 * DIR + h; R.pa = rp[0]; R.pb = rp[16]; }
}
DI void scan_stage0_common(LAS unsigned char* lds, const Pre& R, const f32x4 (&S)[4]) {
    const int tid = threadIdx.x, w = tid >> 6, lane = tid & 63, r = lane & 15, q = lane >> 4;
    const int i = tid >> 4, c16 = tid & 15;
    *(LAS u32x4*)(lds + L_Q + i * 272 + 16 * c16) = R.q0; *(LAS u32x4*)(lds + L_Q + (i + 32) * 272 + 16 * c16) = R.q1;
    *(LAS u32x4*)(lds + L_K + i * 272 + 16 * c16) = R.k0; *(LAS u32x4*)(lds + L_K + (i + 32) * 272 + 16 * c16) = R.k1;
    *(LAS u32x4*)(lds + L_V + (tid >> 3) * 144 + 16 * (tid & 7)) = R.v;
    const int dvt = w & 3, dh = w >> 2;
#pragma unroll
    for (int t = 0; t < 4; ++t) { const int d = 16 * (4 * dh + t) + r; *(LAS u32x2*)(lds + L_SB + d * 144 + (16 * dvt + 4 * q) * 2) = pack4(S[t]); }
}
DI void scan_out(bf16_t* op, f32x4 o, bool second, LAS float* SSP, int i, int dvt, int q) {
    if (second) { const u32x2 prev = *(const u32x2*)op; o[0] += bflo(prev.x); o[1] += bfhi(prev.x); o[2] += bflo(prev.y); o[3] += bfhi(prev.y); }
    const u32x2 pk = pack4(o);
    *(u32x2*)op = pk;
    if (second) {
        const float a0 = bflo(pk.x), a1 = bfhi(pk.x), a2 = bflo(pk.y), a3 = bfhi(pk.y);
        float ssq = (a0 * a0 + a1 * a1) + (a2 * a2 + a3 * a3);
        ssq += __shfl_xor(ssq, 16); ssq += __shfl_xor(ssq, 32);
        if (q == 0) SSP[i * 4 + dvt] = ssq;
    }
}

template <int DIR> DI void gla_step(const Params& p, LAS unsigned char* lds, int b, int h, int s, int st, f32x4 (&S)[4], const bf16x8 lrw, const float lrbias, Pre& R) {
    const int tid = threadIdx.x, w = tid >> 6, lane = tid & 63, r = lane & 15, q = lane >> 4;
    const int cid = chunk_id<DIR>(st); const bool latent = cid >= 4; const int base = gla_base(b, cid);
    const bool second = latent && (DIR == 0 ? (cid - 4 >= 64) : (cid - 4 <= 63));
    LAS float* EG = (LAS float*)(lds + L_SC); LAS float* SSP = (LAS float*)(lds + L_SSP);
    const int dvt = w & 3, ih = w >> 2;
    scan_stage0_common(lds, R, S);
    if (tid < 128) *(LAS u32x4*)(lds + L_X + (tid >> 1) * 80 + 16 * (tid & 1)) = R.x;
    __syncthreads();
    if (DIR == 0) gla_prefetch<1>(p, b, h, s, st, R); else if (st + 1 < NCHUNK) gla_prefetch<0>(p, b, h, s, st + 1, R);
    {
        float g[4][4], Pfx[4][4];
        const f32x4 zero = {0.f, 0.f, 0.f, 0.f};
#pragma unroll
        for (int t = 0; t < 4; ++t) {
            bf16x8 xf = {0, 0, 0, 0, 0, 0, 0, 0};
            if (q < 2) xf = ldsRow(lds + L_X + (16 * t + r) * 80 + 16 * q);
            const f32x4 z = mfma16(xf, lrw, zero);
#pragma unroll
            for (int j = 0; j < 4; ++j) { const float zz = z[j] + lrbias;
                g[t][j] = (fminf(zz, 0.f) * LOG2E - lg2(1.f + ex2(-LOG2E * fabsf(zz)))) * 0.0625f; }
        }
        float run = 0.f;
#pragma unroll
        for (int t = 0; t < 4; ++t) {
            const float c0 = g[t][0], c1 = c0 + g[t][1], c2 = c1 + g[t][2], c3 = c2 + g[t][3];
            const float s0 = __shfl(c3, r), s1 = __shfl(c3, r + 16), s2 = __shfl(c3, r + 32), s3 = __shfl(c3, r + 48);
            const float excl = run + (q > 0 ? s0 : 0.f) + (q > 1 ? s1 : 0.f) + (q > 2 ? s2 : 0.f);
            Pfx[t][0] = excl + c0; Pfx[t][1] = excl + c1; Pfx[t][2] = excl + c2; Pfx[t][3] = excl + c3;
            run += (s0 + s1) + (s2 + s3);
        }
        const int d = 16 * w + r;
#pragma unroll
        for (int t = 0; t < 4; ++t)
#pragma unroll
            for (int j = 0; j < 4; ++j) {
                const float G = DIR == 0 ? Pfx[t][j] : run - Pfx[t][j] + g[t][j];
                const float eq = ex2(G) * 0.08838834764831845f, ek = ex2(-G);
                const int off = (16 * t + 4 * q + j) * 272 + 2 * d;
                LAS bf16_t* qp = (LAS bf16_t*)(lds + L_Q + off); LAS bf16_t* kp = (LAS bf16_t*)(lds + L_K + off);
                *qp = f2bf(bf2f(*qp) * eq); *kp = f2bf(bf2f(*kp) * ek);
            }
        if (q == 0) EG[d] = ex2(run);
    }
    __syncthreads();
    if (latent) {
        const int it2 = w >> 1;
#pragma unroll
        for (int jj = 0; jj < 2; ++jj) {
            const int jt = 2 * (w & 1) + jj; const bool act = DIR == 0 ? (jt <= it2) : (jt >= it2);
            f32x4 acc = {0.f, 0.f, 0.f, 0.f};
            if (act) {
#pragma unroll
                for (int ks = 0; ks < 4; ++ks) acc = mfma16(ldsRow(lds + L_K + (16 * jt + r) * 272 + 64 * ks + 16 * q), ldsRow(lds + L_Q + (16 * it2 + r) * 272 + 64 * ks + 16 * q), acc);
            }
            const int i = 16 * it2 + r;
#pragma unroll
            for (int e = 0; e < 4; ++e) { const int j = 16 * jt + 4 * q + e; const bool keep = DIR == 0 ? (j <= i) : (j >= i); acc[e] = keep ? acc[e] : 0.f; }
            *(LAS u32x2*)(lds + L_A + i * 144 + (16 * jt + 4 * q) * 2) = pack4(acc);
        }
        __syncthreads();
        f32x4 o[2] = {{0.f, 0.f, 0.f, 0.f}, {0.f, 0.f, 0.f, 0.f}};
#pragma unroll
        for (int ks = 0; ks < 2; ++ks) { const bf16x8 X = ldsT(lds + L_V, 144, 32 * ks, 16 * dvt, lane);
#pragma unroll
            for (int u = 0; u < 2; ++u) o[u] = mfma16(X, ldsRow(lds + L_A + (16 * (2 * ih + u) + r) * 144 + 64 * ks + 16 * q), o[u]); }
#pragma unroll
        for (int ks = 0; ks < 4; ++ks) { const bf16x8 X = ldsT(lds + L_SB, 144, 32 * ks, 16 * dvt, lane);
#pragma unroll
            for (int u = 0; u < 2; ++u) o[u] = mfma16(X, ldsRow(lds + L_Q + (16 * (2 * ih + u) + r) * 272 + 64 * ks + 16 * q), o[u]); }
        bf16_t* ob = (bf16_t*)p.out;
#pragma unroll
        for (int u = 0; u < 2; ++u) { const int i = 16 * (2 * ih + u) + r;
            scan_out(ob + (size_t)(base + i) * 2048 + 256 * h + 64 * s + 16 * dvt + 4 * q, o[u], second, SSP, i, dvt, q); }
    }
#pragma unroll
    for (int ks = 0; ks < 2; ++ks) { const bf16x8 X = ldsT(lds + L_V, 144, 32 * ks, 16 * dvt, lane);
#pragma unroll
        for (int t = 0; t < 4; ++t) S[t] = mfma16(X, ldsT(lds + L_K, 272, 32 * ks, 16 * (4 * ih + t), lane), S[t]); }
#pragma unroll
    for (int t = 0; t < 4; ++t) { const float eg = EG[16 * (4 * ih + t) + r]; S[t] = S[t] * eg; }
    __syncthreads();
    if (second && tid < 64) { const f32x4 s4 = *(LAS const f32x4*)(SSP + 4 * tid);
        ((float*)(p.ws + OFF_SS))[(size_t)(4 * h + s) * ML + (base + tid)] = (s4[0] + s4[1]) + (s4[2] + s4[3]); }
}

template <int DIR> DI void gdn_step(const Params& p, LAS unsigned char* lds, int b, int h, int s, int st, f32x4 (&S)[4], Pre& R) {
    const int tid = threadIdx.x, w = tid >> 6, lane = tid & 63, r = lane & 15, q = lane >> 4;
    const int cid = chunk_id<DIR>(st); const bool latent = cid >= 4;
    const bool second = latent && (DIR == 0 ? (cid - 4 >= 64) : (cid - 4 <= 63));
    LAS float* sG = (LAS float*)(lds + L_SC); LAS float* sEG = sG + 64; LAS float* sBeta = sG + 128; LAS float* sEdec = sG + 192; LAS float* sEGend = sG + 256;
    LAS float* SSP = (LAS float*)(lds + L_SSP);
    const int dvt = w & 3, ih = w >> 2;
    scan_stage0_common(lds, R, S);
    *(LAS u32x4*)(lds + L_X + (tid >> 3) * 144 + 16 * (tid & 7)) = R.x;
    if (tid < 64) {
        float g2, beta; gdn_gates(p, DIR, h, bf2f((bf16_t)R.pa), bf2f((bf16_t)R.pb), g2, beta);
        const float Pf = wave_prefix(g2, lane), Tall = __shfl(Pf, 63);
        const float G = DIR == 0 ? Pf : Tall - Pf + g2;
        sG[lane] = G; sEG[lane] = ex2(G); sBeta[lane] = beta; sEdec[lane] = ex2(Tall - G); if (lane == 0) sEGend[0] = ex2(Tall);
    }
    __syncthreads();
    if (DIR == 0) gdn_prefetch<1>(p, b, h, s, st, R); else if (st + 1 < NCHUNK) gdn_prefetch<0>(p, b, h, s, st + 1, R);
    {
        f32x4 pa[2] = {{0.f, 0.f, 0.f, 0.f}, {0.f, 0.f, 0.f, 0.f}};
#pragma unroll
        for (int ks = 0; ks < 4; ++ks) { const bf16x8 X = ldsT(lds + L_SB, 144, 32 * ks, 16 * dvt, lane);
#pragma unroll
            for (int u = 0; u < 2; ++u) pa[u] = mfma16(X, ldsRow(lds + L_K + (16 * (2 * ih + u) + r) * 272 + 64 * ks + 16 * q), pa[u]); }
#pragma unroll
        for (int u = 0; u < 2; ++u) { const int i = 16 * (2 * ih + u) + r; const float eg = sEG[i], be = sBeta[i];
            const u32x2 vv = *(LAS const u32x2*)(lds + L_V + i * 144 + (16 * dvt + 4 * q) * 2);
            f32x4 rr; rr[0] = be * (bflo(vv.x) - eg * pa[u][0]); rr[1] = be * (bfhi(vv.x) - eg * pa[u][1]); rr[2] = be * (bflo(vv.y) - eg * pa[u][2]); rr[3] = be * (bfhi(vv.y) - eg * pa[u][3]);
            *(LAS u32x2*)(lds + L_R + i * 144 + (16 * dvt + 4 * q) * 2) = pack4(rr); }
    }
    if (latent) {
        const int it2 = w >> 1;
#pragma unroll
        for (int jj = 0; jj < 2; ++jj) {
            const int jt = 2 * (w & 1) + jj; const bool act = DIR == 0 ? (jt <= it2) : (jt >= it2);
            f32x4 acc = {0.f, 0.f, 0.f, 0.f};
            if (act) {
#pragma unroll
                for (int ks = 0; ks < 4; ++ks) acc = mfma16(ldsRow(lds + L_K + (16 * jt + r) * 272 + 64 * ks + 16 * q), ldsRow(lds + L_Q + (16 * it2 + r) * 272 + 64 * ks + 16 * q), acc);
            }
            const int i = 16 * it2 + r; const float Gi = sG[i]; const f32x4 Gj = *(LAS const f32x4*)(sG + 16 * jt + 4 * q);
#pragma unroll
            for (int e = 0; e < 4; ++e) { const int j = 16 * jt + 4 * q + e; const bool keep = DIR == 0 ? (j <= i) : (j >= i); acc[e] = keep ? acc[e] * ex2(fminf(Gi - Gj[e], 0.f)) : 0.f; }
            *(LAS u32x2*)(lds + L_A + i * 144 + (16 * jt + 4 * q) * 2) = pack4(acc);
        }
    }
    __syncthreads();
    {
        f32x4 va[2] = {{0.f, 0.f, 0.f, 0.f}, {0.f, 0.f, 0.f, 0.f}};
#pragma unroll
        for (int ks = 0; ks < 2; ++ks) { const bf16x8 X = ldsT(lds + L_R, 144, 32 * ks, 16 * dvt, lane);
#pragma unroll
            for (int u = 0; u < 2; ++u) va[u] = mfma16(X, ldsRow(lds + L_X + (16 * (2 * ih + u) + r) * 144 + 64 * ks + 16 * q), va[u]); }
#pragma unroll
        for (int u = 0; u < 2; ++u) { const int i = 16 * (2 * ih + u) + r; const float ed = sEdec[i];
            *(LAS u32x2*)(lds + L_VN + i * 144 + (16 * dvt + 4 * q) * 2) = pack4(va[u]);
            *(LAS u32x2*)(lds + L_VD + i * 144 + (16 * dvt + 4 * q) * 2) = pack4(va[u] * ed); }
    }
    __syncthreads();
    if (latent) {
        f32x4 o[2] = {{0.f, 0.f, 0.f, 0.f}, {0.f, 0.f, 0.f, 0.f}};
#pragma unroll
        for (int ks = 0; ks < 4; ++ks) { const bf16x8 X = ldsT(lds + L_SB, 144, 32 * ks, 16 * dvt, lane);
#pragma unroll
            for (int u = 0; u < 2; ++u) o[u] = mfma16(X, ldsRow(lds + L_Q + (16 * (2 * ih + u) + r) * 272 + 64 * ks + 16 * q), o[u]); }
#pragma unroll
        for (int u = 0; u < 2; ++u) o[u] = o[u] * sEG[16 * (2 * ih + u) + r];
#pragma unroll
        for (int ks = 0; ks < 2; ++ks) { const bf16x8 X = ldsT(lds + L_VN, 144, 32 * ks, 16 * dvt, lane);
#pragma unroll
            for (int u = 0; u < 2; ++u) o[u] = mfma16(X, ldsRow(lds + L_A + (16 * (2 * ih + u) + r) * 144 + 64 * ks + 16 * q), o[u]); }
        bf16_t* ob = (bf16_t*)p.out;
#pragma unroll
        for (int u = 0; u < 2; ++u) { const int i = 16 * (2 * ih + u) + r;
            scan_out(ob + (size_t)gdn_row(b, cid, i) * 2048 + 1024 + 128 * h + 64 * s + 16 * dvt + 4 * q, o[u], second, SSP, i, dvt, q); }
    }
    {
        const float eg = sEGend[0];
#pragma unroll
        for (int t = 0; t < 4; ++t) S[t] = S[t] * eg;
#pragma unroll
        for (int ks = 0; ks < 2; ++ks) { const bf16x8 X = ldsT(lds + L_VD, 144, 32 * ks, 16 * dvt, lane);
#pragma unroll
            for (int t = 0; t < 4; ++t) S[t] = mfma16(X, ldsT(lds + L_K, 272, 32 * ks, 16 * (4 * ih + t), lane), S[t]); }
    }
    __syncthreads();
    if (second && tid < 64) { const f32x4 s4 = *(LAS const f32x4*)(SSP + 4 * tid);
        ((float*)(p.ws + OFF_SS))[(size_t)(16 + 2 * h + s) * ML + gdn_row(b, cid, tid)] = (s4[0] + s4[1]) + (s4[2] + s4[3]); }
}

DI void phase_scan(const Params& p, LAS unsigned char* lds) {
    const int tid = threadIdx.x, w = tid >> 6, lane = tid & 63, r = lane & 15, q = lane >> 4;
    for (int role = blockIdx.x; role < 256; role += gridDim.x) {
        f32x4 Sf[4], Sb[4];
#pragma unroll
        for (int t = 0; t < 4; ++t) { Sf[t] = (f32x4){0.f, 0.f, 0.f, 0.f}; Sb[t] = (f32x4){0.f, 0.f, 0.f, 0.f}; }
        Pre R; R.q0 = R.q1 = R.k0 = R.k1 = R.v = R.x = (u32x4){0u, 0u, 0u, 0u}; R.pa = R.pb = 0u;
        __syncthreads();
        if (role < 128) {
            const int b = role >> 4, h = (role >> 2) & 3, s = role & 3;
            bf16x8 lw0 = {0, 0, 0, 0, 0, 0, 0, 0}, lw1 = {0, 0, 0, 0, 0, 0, 0, 0};
            const int d = 128 * h + 16 * w + r;
            if (q < 2) {
#pragma unroll
                for (int e = 0; e < 8; ++e) { lw0[e] = (short)f2bf(p.gla_lr_w[(size_t)(8 * q + e) * 512 + d]); lw1[e] = (short)f2bf(p.gla_lr_w[(size_t)(16 + 8 * q + e) * 512 + d]); }
            }
            const float lb0 = p.gla_lr_b[d], lb1 = p.gla_lr_b[512 + d];
            gla_prefetch<0>(p, b, h, s, 0, R);
#pragma unroll 1
            for (int st = 0; st < NCHUNK; ++st) { gla_step<0>(p, lds, b, h, s, st, Sf, lw0, lb0, R); gla_step<1>(p, lds, b, h, s, st, Sb, lw1, lb1, R); }
        } else {
            const int rr = role - 128, b = rr >> 4, h = (rr >> 1) & 7, s = rr & 1;
            gdn_prefetch<0>(p, b, h, s, 0, R);
#pragma unroll 1
            for (int st = 0; st < NCHUNK; ++st) { gdn_step<0>(p, lds, b, h, s, st, Sf, R); gdn_step<1>(p, lds, b, h, s, st, Sb, R); }
        }
    }
}

__global__ __launch_bounds__(512, 2) void mega(Params p) {
    extern __shared__ __attribute__((aligned(16))) unsigned char smem[];
    LAS unsigned char* lds = (LAS unsigned char*)smem;
    const int lo = p.ph_lo, hi = p.ph_hi;
#ifndef ONLY_PHASE
#define ONLY_PHASE -1
#endif
#define IN(k) ((ONLY_PHASE < 0 || ONLY_PHASE == (k)) && lo <= (k) && (k) < hi)
#define SEAM(k) do { if (IN(k) && IN((k) + 1)) cg::this_grid().sync(); } while (0)
    const int G = gridDim.x, c = blockIdx.x;
    if (IN(0)) phase0(p, lds);
    SEAM(0);
    if (IN(1)) phase_hn(p);
    SEAM(1);
    if (IN(2)) { pg8::Gemm g{(const bf16_t*)(p.ws + OFF_HN), (const bf16_t*)(p.ws + OFF_WSCAN), MALL, NSCAN_PAD, DM}; pg8::StaticOrder S; S.init(MALL, NSCAN_PAD, G, c);
        EpiScan E{(bf16_t*)(p.ws + OFF_PSCAN)}; pg8::gemm_phase<EpiScan, pg8::StaticOrder>(lds, g, S, E, nullptr); }
    SEAM(2);
    if (IN(3)) phase_conv(p);
    SEAM(3);
    if (IN(4)) phase_tinv(p, lds);
    SEAM(4);
    if (IN(5)) phase_scan(p, lds);
    SEAM(5);
    if (IN(6)) { pg8::Gemm g{(const bf16_t*)(p.ws + OFF_HN), (const bf16_t*)(p.ws + OFF_WMERGE), ML, NMERGE, DM}; pg8::StaticOrder S; S.init(ML, NMERGE, G, c);
        EpiMerge E{(const bf16_t*)p.out, (const float*)(p.ws + OFF_SS), p.gla_norm_w, p.gdn_norm_w, (bf16_t*)(p.ws + OFF_M)};
        pg8::gemm_phase<EpiMerge, pg8::StaticOrder>(lds, g, S, E, nullptr); }
    SEAM(6);
    if (IN(7)) { pg8::Gemm g{(const bf16_t*)(p.ws + OFF_M), (const bf16_t*)(p.ws + OFF_WOUT), ML, DM, DM}; pg8::StaticOrder S; S.init(ML, DM, G, c);
        EpiRes E{p.x, (const float*)(p.ws + OFF_MOD) + 2048, (float*)(p.ws + OFF_X1)}; pg8::gemm_phase<EpiRes, pg8::StaticOrder>(lds, g, S, E, nullptr); }
    SEAM(7);
    if (IN(8)) phase_hn2(p);
    SEAM(8);
    if (IN(9)) { pg8::Gemm g{(const bf16_t*)(p.ws + OFF_HN), (const bf16_t*)(p.ws + OFF_WGU), ML, NGU, DM}; pg8::StaticOrder S; S.init(ML, NGU, G, c);
        EpiGU E{(bf16_t*)(p.ws + OFF_H)}; pg8::gemm_phase<EpiGU, pg8::StaticOrder>(lds, g, S, E, nullptr); }
    SEAM(9);
    if (IN(10)) { pg8::Gemm g{(const bf16_t*)(p.ws + OFF_H), (const bf16_t*)(p.ws + OFF_WD), ML, DM, FFN}; pg8::StaticOrder S; S.init(ML, DM, G, c);
        EpiRes E{(const float*)(p.ws + OFF_X1), (const float*)(p.ws + OFF_MOD) + 5120, p.out}; pg8::gemm_phase<EpiRes, pg8::StaticOrder>(lds, g, S, E, nullptr); }
    SEAM(10);
    if (IN(11)) phase_final(p);
#undef IN
#undef SEAM
}

extern "C" void kernel_launch(void* const* d_in, const int* in_sizes, int n_in, void* d_out, int out_size, void* d_ws, size_t ws_size, hipStream_t stream) {
    static int grid = 0;
    if (grid == 0) {
        if (n_in != 21 || out_size != ML * DM || ws_size < WS_END) { fprintf(stderr, "kernel_launch: unexpected shapes (n_in %d out %d ws %zu need %zu)\n", n_in, out_size, ws_size, (size_t)WS_END); grid = -1; return; }
        int dev = 0, cus = 0, per_cu = 0;
        hipGetDevice(&dev); hipDeviceGetAttribute(&cus, hipDeviceAttributeMultiprocessorCount, dev);
        if (hipFuncSetAttribute((const void*)mega, hipFuncAttributeMaxDynamicSharedMemorySize, LDS_BYTES) != hipSuccess) { fprintf(stderr, "kernel_launch: hipFuncSetAttribute failed\n"); grid = -1; return; }
        if (hipOccupancyMaxActiveBlocksPerMultiprocessor(&per_cu, (const void*)mega, 512, LDS_BYTES) != hipSuccess || per_cu < 1) { fprintf(stderr, "kernel_launch: occupancy query gave %d\n", per_cu); per_cu = 1; }
        (void)hipGetLastError();
        grid = cus * per_cu;
    }
    if (grid < 0) return;
    Params p{};
    const float** pp = (const float**)&p;
    for (int i = 0; i < 21; ++i) pp[i] = (const float*)d_in[i];
    p.out = (float*)d_out; p.ws = (unsigned char*)d_ws;
#if N_LAUNCHES == 1
    p.ph_lo = 0; p.ph_hi = NPHASE;
    void* args[] = {&p};
    hipError_t e = hipLaunchCooperativeKernel((const void*)mega, dim3(grid), dim3(512), args, LDS_BYTES, stream);
    if (e != hipSuccess) fprintf(stderr, "kernel_launch: cooperative launch failed: %s (grid %d)\n", hipGetErrorString(e), grid);
#else
    for (int k = 0; k < NPHASE; ++k) { p.ph_lo = k; p.ph_hi = k + 1; hipLaunchKernelGGL(mega, dim3(grid), dim3(512), LDS_BYTES, stream, p); }
#endif
}
```

```cpp
#include <hip/hip_runtime.h>
#include <hip/hip_cooperative_groups.h>
#include <cstdio>
#include <cstdint>
namespace pg8 {
#define PG8_LAS __attribute__((address_space(3)))
typedef unsigned short bf16_t;
typedef short bf16x8 __attribute__((ext_vector_type(8)));
typedef float f32x4 __attribute__((ext_vector_type(4)));
typedef unsigned u32x4 __attribute__((ext_vector_type(4)));
constexpr int BM = 256, BK = 64, HALF = 128, HTB = HALF * BK * 2  , STAGE_BYTES = 8 * HTB, NXCD = 8, WGM = 2;

__host__ __device__ __forceinline__ int lds_byte(int r, int c) { const int st = (r >> 4) * 2 + (c >> 5), rr = r & 15, cc = c & 31, ob = rr * 64 + cc * 2; return st * 1024 + (ob ^ (((ob >> 9) & 1) << 5)); }
__host__ __device__ __forceinline__ void stage_rc(int b, int& R, int& C) { const int st = b / 1024, sb = b % 1024, swz = sb ^ (((sb >> 9) & 1) << 5); R = (st >> 1) * 16 + swz / 64; C = (st & 1) * 32 + (swz % 64) / 2; }
__host__ __device__ __forceinline__ int perm32(int rho) { const int n = rho >> 4, i = rho & 15; return 8 * (i >> 2) + 4 * n + (i & 3); }

struct Unit { int pm, pn; };
struct Gemm { const bf16_t* A; const bf16_t* Bt; int M, N, K; };

struct StaticOrder {
    int nM, nN, nwg, G, c;
    __host__ __device__ void init(int M, int N, int G_, int c_) { nM = M / BM; nN = N / BM; nwg = nM * nN; G = G_; c = c_; }
    __host__ __device__ bool next(int i, Unit& u) const {
        const long L = (long)i * G + c; if (L >= nwg) return false;
        int wgid = (int)L; { const int q = nwg / NXCD, r = nwg % NXCD, xcd = wgid % NXCD, off = wgid / NXCD; wgid = (xcd < r ? xcd * (q + 1) : r * (q + 1) + (xcd - r) * q) + off; }
        const int nig = WGM * nN, gid = wgid / nig, fm = gid * WGM, gsz = (nM - fm) < WGM ? (nM - fm) : WGM;
        u.pm = fm + ((wgid % nig) % gsz); u.pn = (wgid % nig) / gsz; return true;
    }
    __device__ __forceinline__ void a_ready(const Unit&) const {}
    __device__ __forceinline__ void done(const Unit&) const {}
};
typedef __bf16 bf16v2_t __attribute__((ext_vector_type(2)));
typedef float f32v2_t __attribute__((ext_vector_type(2)));
__device__ __forceinline__ unsigned cvt_pk_bf16(float lo, float hi) { const f32v2_t f = {lo, hi}; const bf16v2_t v = __builtin_convertvector(f, bf16v2_t); return __builtin_bit_cast(unsigned, v); }
template <class Epi, class Sched, bool ALIGN_EPI = false, bool SP2 = false>
__device__ __forceinline__ void gemm_phase(PG8_LAS unsigned char* lds, const Gemm g, const Sched& S, const Epi& E) {
    const int tid = threadIdx.x, wid = __builtin_amdgcn_readfirstlane(tid >> 6), lane = tid & 63, wr = wid >> 2, wc = wid & 3, fr = lane & 15, fq = lane >> 4;
    const int K = g.K, nt = K / BK;
    unsigned voffA[2], voffB[2];
#pragma unroll
    for (int i = 0; i < 2; ++i) { int R, C; stage_rc(tid * 16 + i * 8192, R, C); const int Rb = Epi::PERM ? ((R & ~31) + perm32(R & 31)) : R;
        voffA[i] = (unsigned)(R * K + C) * 2u; voffB[i] = (unsigned)(Rb * K + C) * 2u; }
    const size_t kstep = (size_t)(BK * 2);
    const size_t hstep = (size_t)HALF * K * 2;
    const size_t tstep = 2 * hstep;
    const unsigned ldsw = (unsigned)wid * 1024u;
    const int aoff = lds_byte(wr * 64 + fr, fq * 8), boff = lds_byte(wc * 32 + fr, fq * 8);
#define PG8_SA(b, h) (((b) * 2 + (h)) * HTB)
#define PG8_SB(b, h) ((4 + (b) * 2 + (h)) * HTB)
#define PG8_STAGE(bufoff, gbase, voff) do { _Pragma("unroll") for (int _i = 0; _i < 2; ++_i) \
        __builtin_amdgcn_global_load_lds((const unsigned*)((const char*)(gbase) + (voff)[_i]), (PG8_LAS unsigned*)(lds + (bufoff) + ldsw + _i * 8192), 16, 0, 0); } while (0)
#define PG8_LDA(dst, b, h) do { _Pragma("unroll") for (int m = 0; m < 4; ++m) _Pragma("unroll") for (int k = 0; k < 2; ++k) dst[m][k] = *(const PG8_LAS bf16x8*)(lds + PG8_SA(b, h) + aoff + m * 2048 + k * 1024); } while (0)
#define PG8_LDB(dst, b, h) do { _Pragma("unroll") for (int n = 0; n < 2; ++n) _Pragma("unroll") for (int k = 0; k < 2; ++k) dst[n][k] = *(const PG8_LAS bf16x8*)(lds + PG8_SB(b, h) + boff + n * 2048 + k * 1024); } while (0)
#define PG8_MMA(ai, bj, At, Bt) do { __builtin_amdgcn_s_setprio(1); _Pragma("unroll") for (int m = 0; m < 4; ++m) _Pragma("unroll") for (int n = 0; n < 2; ++n) _Pragma("unroll") for (int k = 0; k < 2; ++k) \
        acc[ai][bj][m][n] = __builtin_amdgcn_mfma_f32_16x16x32_bf16(Bt[n][k], At[m][k], acc[ai][bj][m][n], 0, 0, 0); __builtin_amdgcn_s_setprio(0); } while (0)
#define PG8_WAIT_V(n) asm volatile("s_waitcnt vmcnt(" #n ")" ::: "memory")
#define PG8_WAIT_L(n) asm volatile("s_waitcnt lgkmcnt(" #n ")" ::: "memory")
#define PG8_BAR __builtin_amdgcn_s_barrier()
#define PG8_SCHED __builtin_amdgcn_sched_barrier(0)
    Unit cur, nxt; int ui = 0;
    if (!S.next(0, cur)) return;
    f32x4 acc[2][2][4][2];
#pragma unroll
    for (int a = 0; a < 2; ++a)
#pragma unroll
        for (int b = 0; b < 2; ++b)
#pragma unroll
            for (int m = 0; m < 4; ++m)
#pragma unroll
                for (int n = 0; n < 2; ++n) acc[a][b][m][n] = (f32x4){0.f, 0.f, 0.f, 0.f};
    bf16x8 At[4][2], B0[2][2], B1[2][2];
    const char* cA = (const char*)g.A + (size_t)cur.pm * tstep; const char* cB = (const char*)g.Bt + (size_t)cur.pn * tstep;
    S.a_ready(cur);
    if constexpr (SP2) {
        PG8_STAGE(PG8_SB(0, 0), cB, voffB); PG8_STAGE(PG8_SB(0, 1), cB + hstep, voffB); PG8_STAGE(PG8_SA(0, 0), cA, voffA); PG8_STAGE(PG8_SA(0, 1), cA + hstep, voffA);
        if (wr == 1) PG8_BAR;
        PG8_WAIT_V(2); PG8_BAR;
        PG8_STAGE(PG8_SB(1, 0), cB + kstep, voffB); PG8_STAGE(PG8_SA(1, 0), cA + kstep, voffA); PG8_STAGE(PG8_SB(1, 1), cB + hstep + kstep, voffB);
        PG8_WAIT_V(6); PG8_BAR;
    } else {
        PG8_STAGE(PG8_SB(0, 0), cB, voffB); PG8_STAGE(PG8_SA(0, 0), cA, voffA); PG8_STAGE(PG8_SB(0, 1), cB + hstep, voffB); PG8_STAGE(PG8_SA(0, 1), cA + hstep, voffA);
        if (wr == 1) PG8_BAR;
        PG8_WAIT_V(4); PG8_BAR;
        PG8_STAGE(PG8_SB(1, 0), cB + kstep, voffB); PG8_STAGE(PG8_SA(1, 0), cA + kstep, voffA); PG8_STAGE(PG8_SB(1, 1), cB + hstep + kstep, voffB);
        PG8_WAIT_V(6); PG8_BAR;
    }
    for (;;) {
        const bool has_next = S.next(ui + 1, nxt);
        const char* nA = has_next ? (const char*)g.A + (size_t)nxt.pm * tstep : cA; const char* nB = has_next ? (const char*)g.Bt + (size_t)nxt.pn * tstep : cB;
        for (int t = 0; t < nt; t += 2) {
            const bool last = (t == nt - 2);
            const char* a1 = cA + (size_t)(t + 1) * kstep;
            const char* a2 = last ? nA : cA + (size_t)(t + 2) * kstep; const char* b2 = last ? nB : cB + (size_t)(t + 2) * kstep;
            const char* a3 = a2 + kstep; const char* b3 = b2 + kstep;
            if (last && has_next) S.a_ready(nxt);
            if constexpr (SP2) {
            PG8_LDB(B0, 0, 0); PG8_LDB(B1, 0, 1); PG8_SCHED; PG8_LDA(At, 0, 0); PG8_STAGE(PG8_SA(1, 1), a1 + hstep, voffA);
            PG8_WAIT_V(8); PG8_WAIT_L(0); PG8_BAR; PG8_MMA(0, 0, At, B0); PG8_MMA(0, 1, At, B1); PG8_BAR; PG8_SCHED;
            PG8_LDA(At, 0, 1); PG8_STAGE(PG8_SB(0, 0), b2, voffB); PG8_STAGE(PG8_SB(0, 1), b2 + hstep, voffB); PG8_STAGE(PG8_SA(0, 0), a2, voffA);
            PG8_WAIT_V(8); PG8_WAIT_L(0); PG8_BAR; PG8_MMA(1, 0, At, B0); PG8_MMA(1, 1, At, B1); PG8_BAR; PG8_SCHED;
            PG8_LDB(B0, 1, 0); PG8_LDB(B1, 1, 1); PG8_SCHED; PG8_LDA(At, 1, 0); PG8_STAGE(PG8_SA(0, 1), a2 + hstep, voffA);
            PG8_WAIT_V(8); PG8_WAIT_L(0); PG8_BAR; PG8_MMA(0, 0, At, B0); PG8_MMA(0, 1, At, B1); PG8_BAR; PG8_SCHED;
            PG8_LDA(At, 1, 1); PG8_STAGE(PG8_SB(1, 0), b3, voffB); PG8_STAGE(PG8_SB(1, 1), b3 + hstep, voffB); PG8_STAGE(PG8_SA(1, 0), a3, voffA);
            PG8_WAIT_V(8); PG8_WAIT_L(0); PG8_BAR; PG8_MMA(1, 0, At, B0); PG8_MMA(1, 1, At, B1); PG8_BAR; PG8_SCHED;
            } else {
            PG8_LDB(B0, 0, 0); PG8_SCHED; PG8_LDA(At, 0, 0); PG8_STAGE(PG8_SA(1, 1), a1 + hstep, voffA);
            PG8_WAIT_L(8); PG8_BAR; PG8_WAIT_L(0); PG8_MMA(0, 0, At, B0); PG8_BAR; PG8_SCHED;
            PG8_LDB(B1, 0, 1); PG8_STAGE(PG8_SB(0, 0), b2, voffB);
            PG8_BAR; PG8_WAIT_L(0); PG8_MMA(0, 1, At, B1); PG8_BAR;
            PG8_LDA(At, 0, 1); PG8_STAGE(PG8_SA(0, 0), a2, voffA);
            PG8_BAR; PG8_WAIT_L(0); PG8_MMA(1, 0, At, B0); PG8_BAR; PG8_SCHED;
            PG8_STAGE(PG8_SB(0, 1), b2 + hstep, voffB);
            PG8_WAIT_V(6); PG8_BAR; PG8_MMA(1, 1, At, B1); PG8_BAR;
            PG8_LDB(B0, 1, 0); PG8_SCHED; PG8_LDA(At, 1, 0); PG8_STAGE(PG8_SA(0, 1), a2 + hstep, voffA);
            PG8_WAIT_L(8); PG8_BAR; PG8_WAIT_L(0); PG8_MMA(0, 0, At, B0); PG8_BAR; PG8_SCHED;
            PG8_LDB(B1, 1, 1); PG8_STAGE(PG8_SB(1, 0), b3, voffB);
            PG8_BAR; PG8_WAIT_L(0); PG8_MMA(0, 1, At, B1); PG8_BAR;
            PG8_LDA(At, 1, 1); PG8_STAGE(PG8_SA(1, 0), a3, voffA);
            PG8_BAR; PG8_WAIT_L(0); PG8_MMA(1, 0, At, B0); PG8_BAR; PG8_SCHED;
            PG8_STAGE(PG8_SB(1, 1), b3 + hstep, voffB);
            PG8_WAIT_V(6); PG8_BAR; PG8_MMA(1, 1, At, B1); PG8_BAR;
            }
        }
        if constexpr (ALIGN_EPI) { if (wr == 0) PG8_BAR; }
        if constexpr (!Epi::AFTER_DRAIN) { E(acc, cur, wr, wc, fr, fq); S.done(cur); }
        if (!has_next) break;
#pragma unroll
        for (int a = 0; a < 2; ++a)
#pragma unroll
            for (int b = 0; b < 2; ++b)
#pragma unroll
                for (int m = 0; m < 4; ++m)
#pragma unroll
                    for (int n = 0; n < 2; ++n) acc[a][b][m][n] = (f32x4){0.f, 0.f, 0.f, 0.f};
        cur = nxt; cA = nA; cB = nB; ++ui;
        if constexpr (ALIGN_EPI) { if (wr == 1) PG8_BAR; }
    }
    PG8_WAIT_V(0);
    if constexpr (!ALIGN_EPI) { if (wr == 0) PG8_BAR; }
    PG8_BAR;
    if constexpr (Epi::AFTER_DRAIN) { E.fused(acc, cur, wr, wc, fr, fq, lds, wid, lane); S.done(cur); }
#undef PG8_SA
#undef PG8_SB
#undef PG8_STAGE
#undef PG8_LDA
#undef PG8_LDB
#undef PG8_MMA
#undef PG8_WAIT_V
#undef PG8_WAIT_L
#undef PG8_BAR
#undef PG8_SCHED
}
}

namespace cg = cooperative_groups;
using pg8::bf16_t; using pg8::bf16x8; using pg8::f32x4; using pg8::u32x4;
typedef short s16x4 __attribute__((ext_vector_type(4)));
typedef unsigned u32x2 __attribute__((ext_vector_type(2)));
typedef float f32x2 __attribute__((ext_vector_type(2)));
#define LAS __attribute__((address_space(3)))
#define DI __device__ __forceinline__

#ifndef GEMM_ALIGN
#define GEMM_ALIGN true
#endif
#ifndef GEMM_SP2
#define GEMM_SP2 true
#endif
#ifndef N_LAUNCHES
#define N_LAUNCHES 1
#endif

constexpr int DM = 1024, NB = 8, SEQ = 8192, CTXL = 256;
constexpr int ML = NB * SEQ, MC = NB * CTXL, MALL = ML + MC;
constexpr int NSCAN = 5184, NSCAN_PAD = 5376, NMERGE = 4096, FFN = 2816, NGU = 5632;
constexpr int NCHUNK = 132, NPHASE = 12;
constexpr float EPSF = 1e-6f, LOG2E = 1.4426950408889634f, LN2 = 0.6931471805599453f;

constexpr size_t OFF_WSCAN = 0;
constexpr size_t OFF_WMERGE = OFF_WSCAN + (size_t)NSCAN_PAD * DM * 2;
constexpr size_t OFF_WOUT = OFF_WMERGE + (size_t)NMERGE * DM * 2;
constexpr size_t OFF_WGU = OFF_WOUT + (size_t)DM * DM * 2;
constexpr size_t OFF_WD = OFF_WGU + (size_t)NGU * DM * 2;
constexpr size_t OFF_MOD = OFF_WD + (size_t)DM * FFN * 2;
constexpr size_t OFF_SS = OFF_MOD + 221184;
constexpr size_t OFF_HN = OFF_SS + (size_t)ML * 32 * 4;
constexpr size_t OFF_TINV = OFF_HN + (size_t)MALL * DM * 2;
constexpr size_t OFF_PSCAN = OFF_TINV + (size_t)NCHUNK * NB * 8 * 2 * 4096 * 2;
constexpr size_t WS_END = OFF_PSCAN + (size_t)MALL * NSCAN * 2;
constexpr size_t OFF_M = OFF_PSCAN;
constexpr size_t OFF_H = OFF_PSCAN;
constexpr size_t OFF_X1 = OFF_PSCAN + (size_t)ML * FFN * 2;
static_assert(OFF_X1 + (size_t)ML * DM * 4 <= WS_END, "overlay");
static_assert(WS_END + 4096 + 16384 <= (size_t)1073741824, "workspace");
constexpr size_t OFF_Y1 = OFF_X1;
constexpr size_t OFF_Y2 = OFF_TINV;
constexpr size_t OFF_CTR = WS_END;
constexpr size_t OFF_XBAR = WS_END + 4096;
constexpr int LDS_XB = 147456, LDS_BYTES = 147456 + 16;

struct Params {
    const float *x, *c, *ctx, *c_ctx, *w_mod, *b_mod, *norm1_w, *norm2_w, *w_in, *gla_lr_w, *gla_lr_b, *gla_norm_w, *gdn_conv_w, *gdn_a_log,
        *gdn_dt_bias, *gdn_norm_w, *w_out, *ffn_w_gate, *ffn_w_up, *ffn_w_down, *final_norm_w;
    float* out; unsigned char* ws; int ph_lo, ph_hi;
};

DI float wave_sum(float v) {
#pragma unroll
    for (int o = 1; o < 64; o <<= 1) v += __shfl_xor(v, o);
    return v;
}
DI unsigned pk2(float lo, float hi) { return pg8::cvt_pk_bf16(lo, hi); }
DI float bflo(unsigned w) { return __uint_as_float(w << 16); }
DI float bfhi(unsigned w) { return __uint_as_float(w & 0xffff0000u); }
DI float bf2f(bf16_t v) { return __uint_as_float(((unsigned)v) << 16); }
DI bf16_t f2bf(float f) { return (bf16_t)(pk2(f, 0.f) & 0xffffu); }
DI float ex2(float x) { return __builtin_amdgcn_exp2f(x); }
DI float lg2(float x) { return __builtin_amdgcn_logf(x); }
DI float rcpf_(float x) { return __builtin_amdgcn_rcpf(x); }
DI float sigm(float x) { return rcpf_(1.f + ex2(-LOG2E * x)); }
DI float silu_(float x) { return x * sigm(x); }
DI float softplus_(float x) {
    const float t = ex2(-LOG2E * fabsf(x));
    const float l = t < 0.01f ? t * (1.f - t * (0.5f - t * 0.33333333f)) : LN2 * lg2(1.f + t);
    return fmaxf(x, 0.f) + l;
}
DI f32x4 mfma16(bf16x8 a, bf16x8 b, f32x4 c) { return __builtin_amdgcn_mfma_f32_16x16x32_bf16(a, b, c, 0, 0, 0); }
DI bf16x8 ldsRow(LAS const unsigned char* p) { return *(LAS const bf16x8*)p; }
DI bf16x8 ldsT(LAS const unsigned char* img, int pitch, int k0, int m0, int lane) {
    const int g = lane >> 4, i16 = lane & 15;
    LAS const unsigned char* a = img + (k0 + 8 * g + (i16 >> 2)) * pitch + 2 * m0 + 8 * (i16 & 3);
    const s16x4 lo = __builtin_amdgcn_ds_read_tr16_b64_v4i16((LAS s16x4*)a);
    const s16x4 hi = __builtin_amdgcn_ds_read_tr16_b64_v4i16((LAS s16x4*)(a + 4 * pitch));
    return __builtin_shufflevector(lo, hi, 0, 1, 2, 3, 4, 5, 6, 7);
}
DI u32x2 pack4(f32x4 v) { u32x2 o; o.x = pk2(v[0], v[1]); o.y = pk2(v[2], v[3]); return o; }
DI void lds_wait() { asm volatile("s_waitcnt lgkmcnt(0)" ::: "memory"); }
DI void lds_barrier() { asm volatile("s_waitcnt lgkmcnt(0)" ::: "memory"); __builtin_amdgcn_s_barrier(); asm volatile("" ::: "memory"); }

DI void tr_item(const float* W, int ldw, int srccol, int k0, bf16_t* dst, int K, LAS float* scr, int lane) {
#pragma unroll 8
    for (int i = 0; i < 32; ++i) { const int kk = 2 * i + (lane >> 5); scr[kk * 33 + (lane & 31)] = srccol >= 0 ? W[(size_t)(k0 + kk) * ldw + srccol] : 0.f; }
    lds_wait();
    const int c = lane & 7;
#pragma unroll
    for (int j = 0; j < 4; ++j) { const int n = (lane >> 3) + 8 * j; LAS const float* s = scr + (8 * c) * 33 + n;
        u32x4 o; o.x = pk2(s[0], s[33]); o.y = pk2(s[66], s[99]); o.z = pk2(s[132], s[165]); o.w = pk2(s[198], s[231]);
        *(u32x4*)(dst + (size_t)n * K + 8 * c) = o; }
    lds_wait();
}
DI int src_scan(int n) { return n < 2048 ? n : (n < 5120 ? 3104 + (n - 2048) : (n < 5152 ? 3072 + (n - 5120) : (n < 5184 ? 7200 + (n - 5152) : -1))); }
DI int src_merge(int n) {
    const int pn = n >> 8, ct = n & 255, bj = ct >> 7, wc = (ct >> 5) & 3, nn = (ct >> 4) & 1, r = ct & 15, ch = 64 * pn + 16 * wc + r;
    const int base = bj == 0 ? (nn == 0 ? 2048 : 7232) : (nn == 0 ? 6176 : 8256);
    return base + ch;
}
DI void phase0(const Params& p, LAS unsigned char* lds) {
    const int tid = threadIdx.x, wave = tid >> 6, lane = tid & 63;
    const int gw = blockIdx.x * 8 + wave, NGW = gridDim.x * 8;
    LAS float* scr = (LAS float*)(lds + wave * 8448);
    bf16_t* Wscan = (bf16_t*)(p.ws + OFF_WSCAN); bf16_t* Wmerge = (bf16_t*)(p.ws + OFF_WMERGE); bf16_t* Wout = (bf16_t*)(p.ws + OFF_WOUT);
    bf16_t* Wgu = (bf16_t*)(p.ws + OFF_WGU); bf16_t* Wd = (bf16_t*)(p.ws + OFF_WD);
    constexpr int I_SCAN = 16 * (NSCAN_PAD / 32), I_MERGE = 16 * (NMERGE / 32), I_OUT = 16 * 32, I_GU = 16 * (NGU / 32), I_D = (FFN / 64) * 32;
    constexpr int NITEMS = I_SCAN + I_MERGE + I_OUT + I_GU + I_D;
    if (blockIdx.x == 0 && tid == 0) *(unsigned*)(p.ws + OFF_CTR) = 0u;
    {
        LAS float* st = (LAS float*)(lds + 8 * 8448);
        for (int idx = tid; idx < 9 * 1024; idx += 512) { const int b = idx >> 10, k = idx & 1023; st[idx] = silu_(b < 8 ? p.c[b * DM + k] : p.c_ctx[k]); }
        __syncthreads();
    }
    for (int it = gw; it < NITEMS; it += NGW) {
        int r = it;
        if (r < I_SCAN) { const int nblk = NSCAN_PAD / 32, kb = r / nblk, nb = r % nblk, n0 = 32 * nb;
            tr_item(p.w_in, 9280, src_scan(n0 + (lane & 31)), 64 * kb, Wscan + (size_t)n0 * DM + 64 * kb, DM, scr, lane); continue; }
        r -= I_SCAN;
        if (r < I_MERGE) { const int nblk = NMERGE / 32, kb = r / nblk, nb = r % nblk, n0 = 32 * nb;
            tr_item(p.w_in, 9280, src_merge(n0 + (lane & 31)), 64 * kb, Wmerge + (size_t)n0 * DM + 64 * kb, DM, scr, lane); continue; }
        r -= I_MERGE;
        if (r < I_OUT) { const int nblk = 32, kb = r / nblk, nb = r % nblk, n0 = 32 * nb;
            tr_item(p.w_out, DM, n0 + (lane & 31), 64 * kb, Wout + (size_t)n0 * DM + 64 * kb, DM, scr, lane); continue; }
        r -= I_OUT;
        if (r < I_GU) { const int nblk = NGU / 32, kb = r / nblk, nb = r % nblk, n0 = 32 * nb;
            const int pn = n0 >> 8, ct = n0 & 255; const float* W = ct < 128 ? p.ffn_w_gate : p.ffn_w_up; const int c0 = 128 * pn + (ct & 127);
            tr_item(W, FFN, c0 + (lane & 31), 64 * kb, Wgu + (size_t)n0 * DM + 64 * kb, DM, scr, lane); continue; }
        r -= I_GU;
        { const int nblk = 32, kb = r / nblk, nb = r % nblk, n0 = 32 * nb;
            tr_item(p.ffn_w_down, DM, n0 + (lane & 31), 64 * kb, Wd + (size_t)n0 * FFN + 64 * kb, FFN, scr, lane); }
    }
    float* mod = (float*)(p.ws + OFF_MOD);
    LAS const float* stab = (LAS const float*)(lds + 8 * 8448);
    for (int it = gw; it < 384; it += NGW) {
        const int col = it * 16 + (lane & 15), kq = lane >> 4;
        float acc[9];
#pragma unroll
        for (int b = 0; b < 9; ++b) acc[b] = 0.f;
#pragma unroll 8
        for (int kk = 0; kk < 256; ++kk) {
            const int k = 256 * kq + kk;
            const float w = p.w_mod[(size_t)k * 6144 + col];
#pragma unroll
            for (int b = 0; b < 9; ++b) acc[b] += stab[b * 1024 + k] * w;
        }
#pragma unroll
        for (int b = 0; b < 9; ++b) { acc[b] += __shfl_xor(acc[b], 16); acc[b] += __shfl_xor(acc[b], 32); }
        if (kq == 0) { const float bias = p.b_mod[col];
#pragma unroll
            for (int b = 0; b < 9; ++b) mod[b * 6144 + col] = acc[b] + bias; }
    }
}

DI void norm_mod_row(const float* xr, bf16_t* orow, const float* nw, const float* shift, const float* scale, int lane) {
    f32x4 v[4]; float s = 0.f;
#pragma unroll
    for (int j = 0; j < 4; ++j) { v[j] = *(const f32x4*)(xr + 4 * lane + 256 * j); s += (v[j][0] * v[j][0] + v[j][1] * v[j][1]) + (v[j][2] * v[j][2] + v[j][3] * v[j][3]); }
    const float rstd = rsqrtf(wave_sum(s) * (1.f / DM) + EPSF);
#pragma unroll
    for (int j = 0; j < 4; ++j) {
        const int cidx = 4 * lane + 256 * j;
        const f32x4 w = *(const f32x4*)(nw + cidx), sh = *(const f32x4*)(shift + cidx), sc = *(const f32x4*)(scale + cidx);
        f32x4 y;
#pragma unroll
        for (int e = 0; e < 4; ++e) y[e] = (v[j][e] * rstd * w[e]) * (1.f + sc[e]) + sh[e];
        *(u32x2*)(orow + cidx) = pack4(y);
    }
}
DI void phase_hn(const Params& p) {
    const int wave = threadIdx.x >> 6, lane = threadIdx.x & 63, gw = blockIdx.x * 8 + wave, NGW = gridDim.x * 8;
    const float* mod = (const float*)(p.ws + OFF_MOD); bf16_t* hn = (bf16_t*)(p.ws + OFF_HN);
    for (int r = gw; r < MALL; r += NGW) {
        const float* xr = r < ML ? p.x + (size_t)r * DM : p.ctx + (size_t)(r - ML) * DM;
        const int mb = r < ML ? r / SEQ : 8;
        norm_mod_row(xr, hn + (size_t)r * DM, p.norm1_w, mod + mb * 6144, mod + mb * 6144 + 1024, lane);
    }
}
DI void phase_hn2(const Params& p) {
    const int wave = threadIdx.x >> 6, lane = threadIdx.x & 63, gw = blockIdx.x * 8 + wave, NGW = gridDim.x * 8;
    const float* mod = (const float*)(p.ws + OFF_MOD); bf16_t* hn = (bf16_t*)(p.ws + OFF_HN); const bf16_t* y1 = (const bf16_t*)(p.ws + OFF_Y1);
    for (int r = gw; r < ML; r += NGW) {
        const int mb = r / SEQ; const float* xr = p.x + (size_t)r * DM; const bf16_t* yr = y1 + (size_t)r * DM; bf16_t* orow = hn + (size_t)r * DM;
        f32x4 v[4]; float s = 0.f;
#pragma unroll
        for (int j = 0; j < 4; ++j) { const int cidx = 4 * lane + 256 * j; const u32x2 yy = *(const u32x2*)(yr + cidx); v[j] = *(const f32x4*)(xr + cidx);
            v[j][0] += bflo(yy.x); v[j][1] += bfhi(yy.x); v[j][2] += bflo(yy.y); v[j][3] += bfhi(yy.y);
            s += (v[j][0] * v[j][0] + v[j][1] * v[j][1]) + (v[j][2] * v[j][2] + v[j][3] * v[j][3]); }
        const float rstd = rsqrtf(wave_sum(s) * (1.f / DM) + EPSF);
        const float* shift = mod + mb * 6144 + 3072; const float* scale = mod + mb * 6144 + 4096;
#pragma unroll
        for (int j = 0; j < 4; ++j) {
            const int cidx = 4 * lane + 256 * j;
            const f32x4 w = *(const f32x4*)(p.norm2_w + cidx), sh = *(const f32x4*)(shift + cidx), sc = *(const f32x4*)(scale + cidx);
            f32x4 y;
#pragma unroll
            for (int e = 0; e < 4; ++e) y[e] = (v[j][e] * rstd * w[e]) * (1.f + sc[e]) + sh[e];
            *(u32x2*)(orow + cidx) = pack4(y);
        }
    }
}
DI void phase_final(const Params& p) {
    const int wave = threadIdx.x >> 6, lane = threadIdx.x & 63, gw = blockIdx.x * 8 + wave, NGW = gridDim.x * 8;
    const bf16_t* y1 = (const bf16_t*)(p.ws + OFF_Y1); const bf16_t* y2 = (const bf16_t*)(p.ws + OFF_Y2);
    for (int r = gw; r < ML; r += NGW) {
        const float* xr = p.x + (size_t)r * DM; const bf16_t* yr = y2 + (size_t)r * DM; const bf16_t* y1r = y1 + (size_t)r * DM; float* orow = p.out + (size_t)r * DM;
        f32x4 v[4]; float s = 0.f;
#pragma unroll
        for (int j = 0; j < 4; ++j) { const int cidx = 4 * lane + 256 * j; const u32x2 yy = *(const u32x2*)(yr + cidx), y1v = *(const u32x2*)(y1r + cidx); v[j] = *(const f32x4*)(xr + cidx);
            v[j][0] += bflo(y1v.x); v[j][1] += bfhi(y1v.x); v[j][2] += bflo(y1v.y); v[j][3] += bfhi(y1v.y);
            v[j][0] += bflo(yy.x); v[j][1] += bfhi(yy.x); v[j][2] += bflo(yy.y); v[j][3] += bfhi(yy.y);
            s += (v[j][0] * v[j][0] + v[j][1] * v[j][1]) + (v[j][2] * v[j][2] + v[j][3] * v[j][3]); }
        const float rstd = rsqrtf(wave_sum(s) * (1.f / DM) + EPSF);
#pragma unroll
        for (int j = 0; j < 4; ++j) { const f32x4 w = *(const f32x4*)(p.final_norm_w + 4 * lane + 256 * j); f32x4 y;
#pragma unroll
            for (int e = 0; e < 4; ++e) y[e] = v[j][e] * rstd * w[e];
            *(f32x4*)(orow + 4 * lane + 256 * j) = y; }
    }
}

struct EpiScan {
    static constexpr bool PERM = true, AFTER_DRAIN = false;
    bf16_t* O;
    __device__ __forceinline__ void operator()(const f32x4 (&acc)[2][2][4][2], const pg8::Unit& u, int wr, int wc, int fr, int fq) const {
        const int row0 = u.pm * 256 + wr * 64 + fr, colt = u.pn * 256 + wc * 32 + 8 * fq;
#pragma unroll
        for (int ai = 0; ai < 2; ++ai)
#pragma unroll
            for (int m = 0; m < 4; ++m) { bf16_t* rowp = O + (size_t)(row0 + ai * 128 + m * 16) * NSCAN + colt;
#pragma unroll
                for (int bj = 0; bj < 2; ++bj) if (colt + bj * 128 < NSCAN) {
                    const f32x4 v0 = acc[ai][bj][m][0], v1 = acc[ai][bj][m][1];
                    u32x4 w; w.x = pk2(v0[0], v0[1]); w.y = pk2(v0[2], v0[3]); w.z = pk2(v1[0], v1[1]); w.w = pk2(v1[2], v1[3]);
                    *(u32x4*)(rowp + bj * 128) = w; } }
    }
};
struct EpiMerge {
    static constexpr bool PERM = false, AFTER_DRAIN = false;
    const bf16_t* O; const float* ss; const float* gw_gla; const float* gw_gdn; bf16_t* Mo;
    __device__ __forceinline__ void operator()(const f32x4 (&acc)[2][2][4][2], const pg8::Unit& u, int wr, int wc, int fr, int fq) const {
        const int ch = u.pn * 64 + wc * 16 + 4 * fq, hg = ch >> 8, hd = ch >> 7;
        const f32x4 gg = *(const f32x4*)(gw_gla + ch), gd = *(const f32x4*)(gw_gdn + ch);
        const int rowb = u.pm * 256 + wr * 64 + fr;
#pragma unroll
        for (int ai = 0; ai < 2; ++ai) {
            u32x2 og[4], od[4]; f32x4 s4[4]; f32x2 s2[4];
#pragma unroll
            for (int m = 0; m < 4; ++m) { const size_t row = (size_t)(rowb + ai * 128 + m * 16);
                og[m] = *(const u32x2*)(O + row * 2048 + ch); od[m] = *(const u32x2*)(O + row * 2048 + 1024 + ch);
                s4[m] = *(const f32x4*)(ss + row * 32 + 4 * hg); s2[m] = *(const f32x2*)(ss + row * 32 + 16 + 2 * hd); }
#pragma unroll
            for (int m = 0; m < 4; ++m) {
                const int row = rowb + ai * 128 + m * 16;
                const float rg = rsqrtf(((s4[m][0] + s4[m][1]) + (s4[m][2] + s4[m][3])) * (1.f / 256.f) + EPSF), rd = rsqrtf((s2[m][0] + s2[m][1]) * (1.f / 128.f) + EPSF);
                const float ogf[4] = {bflo(og[m].x), bfhi(og[m].x), bflo(og[m].y), bfhi(og[m].y)}, odf[4] = {bflo(od[m].x), bfhi(od[m].x), bflo(od[m].y), bfhi(od[m].y)};
                f32x4 mv;
#pragma unroll
                for (int j = 0; j < 4; ++j) {
                    const float zg = acc[ai][0][m][0][j], ggv = acc[ai][0][m][1][j], zd = acc[ai][1][m][0][j], gdv = acc[ai][1][m][1][j];
                    const float dg = (1.f + ex2(-LOG2E * zg)) * (1.f + ex2(-LOG2E * ggv)), dd = (1.f + ex2(-LOG2E * zd)) * (1.f + ex2(-LOG2E * gdv));
                    mv[j] = ogf[j] * rg * gg[j] * zg * rcpf_(dg) + odf[j] * rd * gd[j] * zd * rcpf_(dd);
                }
                *(u32x2*)(Mo + (size_t)row * DM + ch) = pack4(mv);
            }
        }
    }
};
struct EpiRes {
    static constexpr bool PERM = false, AFTER_DRAIN = false;
    const float* base; const float* gate; float* Out;
    __device__ __forceinline__ void operator()(const f32x4 (&acc)[2][2][4][2], const pg8::Unit& u, int wr, int wc, int fr, int fq) const {
        const int row0 = u.pm * 256 + wr * 64 + fr, col0 = u.pn * 256 + wc * 32 + 4 * fq, b = u.pm >> 5;
        f32x4 gv[2][2];
#pragma unroll
        for (int bj = 0; bj < 2; ++bj)
#pragma unroll
            for (int n = 0; n < 2; ++n) gv[bj][n] = *(const f32x4*)(gate + b * 6144 + col0 + bj * 128 + n * 16);
#pragma unroll
        for (int ai = 0; ai < 2; ++ai)
#pragma unroll
            for (int m = 0; m < 4; ++m) { const size_t ro = (size_t)(row0 + ai * 128 + m * 16) * DM + col0;
#pragma unroll
                for (int bj = 0; bj < 2; ++bj)
#pragma unroll
                    for (int n = 0; n < 2; ++n) { const f32x4 bv = *(const f32x4*)(base + ro + bj * 128 + n * 16);
                        *(f32x4*)(Out + ro + bj * 128 + n * 16) = bv + gv[bj][n] * acc[ai][bj][m][n]; } }
    }
};
struct EpiY {
    static constexpr bool PERM = true, AFTER_DRAIN = false;
    const float* gate; bf16_t* Y;
    __device__ __forceinline__ void operator()(const f32x4 (&acc)[2][2][4][2], const pg8::Unit& u, int wr, int wc, int fr, int fq) const {
        const int row0 = u.pm * 256 + wr * 64 + fr, col0 = u.pn * 256 + wc * 32 + 8 * fq, b = u.pm >> 5;
        f32x4 gv[2][2];
#pragma unroll
        for (int bj = 0; bj < 2; ++bj)
#pragma unroll
            for (int n = 0; n < 2; ++n) gv[bj][n] = *(const f32x4*)(gate + b * 6144 + col0 + bj * 128 + 4 * n);
#pragma unroll
        for (int ai = 0; ai < 2; ++ai)
#pragma unroll
            for (int m = 0; m < 4; ++m) { bf16_t* rowp = Y + (size_t)(row0 + ai * 128 + m * 16) * DM + col0;
#pragma unroll
                for (int bj = 0; bj < 2; ++bj) { const f32x4 v0 = acc[ai][bj][m][0] * gv[bj][0], v1 = acc[ai][bj][m][1] * gv[bj][1];
                    u32x4 w; w.x = pk2(v0[0], v0[1]); w.y = pk2(v0[2], v0[3]); w.z = pk2(v1[0], v1[1]); w.w = pk2(v1[2], v1[3]);
                    *(u32x4*)(rowp + bj * 128) = w; } }
    }
};
struct EpiGU {
    static constexpr bool PERM = true, AFTER_DRAIN = false;
    bf16_t* H;
    __device__ __forceinline__ void operator()(const f32x4 (&acc)[2][2][4][2], const pg8::Unit& u, int wr, int wc, int fr, int fq) const {
        const int row0 = u.pm * 256 + wr * 64 + fr, col0 = u.pn * 128 + wc * 32 + 8 * fq;
#pragma unroll
        for (int ai = 0; ai < 2; ++ai)
#pragma unroll
            for (int m = 0; m < 4; ++m) {
                f32x4 h0, h1;
#pragma unroll
                for (int j = 0; j < 4; ++j) { h0[j] = silu_(acc[ai][0][m][0][j]) * acc[ai][1][m][0][j]; h1[j] = silu_(acc[ai][0][m][1][j]) * acc[ai][1][m][1][j]; }
                u32x4 w; w.x = pk2(h0[0], h0[1]); w.y = pk2(h0[2], h0[3]); w.z = pk2(h1[0], h1[1]); w.w = pk2(h1[2], h1[3]);
                *(u32x4*)(H + (size_t)(row0 + ai * 128 + m * 16) * FFN + col0) = w; }
    }
};

template <int RPL>
DI void conv_tile(bf16_t* P, size_t row0, size_t rstride, int slice, const float* conv_w, int wave, int lane) {
    constexpr int NR = 32 * RPL;
    const int rq = lane >> 4, cl = lane & 15, rbase = (wave * 4 + rq) * RPL, ch = slice * 128 + cl * 8;
    bf16_t* colp = P + 2048 + ch;
    u32x4 in[RPL + 4];
#pragma unroll
    for (int t = 0; t < RPL + 4; ++t) { const int r = rbase + t - 2;
        in[t] = (r >= 0 && r < NR) ? *(const u32x4*)(colp + (row0 + (size_t)r * rstride) * NSCAN) : (u32x4){0u, 0u, 0u, 0u}; }
    float w[5][8];
#pragma unroll
    for (int i = 0; i < 5; ++i) { const f32x4 a = *(const f32x4*)(conv_w + i * 3072 + ch), b = *(const f32x4*)(conv_w + i * 3072 + ch + 4);
#pragma unroll
        for (int e = 0; e < 4; ++e) { w[i][e] = a[e]; w[i][4 + e] = b[e]; } }
    asm volatile("s_waitcnt vmcnt(0)" ::: "memory");
    __syncthreads();
#pragma unroll
    for (int t = 0; t < RPL; ++t) {
        float acc[8];
#pragma unroll
        for (int e = 0; e < 8; ++e) acc[e] = 0.f;
#pragma unroll
        for (int i = 0; i < 5; ++i) { const u32x4 v = in[t + i];
            acc[0] += w[i][0] * bflo(v.x); acc[1] += w[i][1] * bfhi(v.x); acc[2] += w[i][2] * bflo(v.y); acc[3] += w[i][3] * bfhi(v.y);
            acc[4] += w[i][4] * bflo(v.z); acc[5] += w[i][5] * bfhi(v.z); acc[6] += w[i][6] * bflo(v.w); acc[7] += w[i][7] * bfhi(v.w); }
        float ssq = 0.f;
#pragma unroll
        for (int e = 0; e < 8; ++e) { acc[e] = silu_(acc[e]); ssq += acc[e] * acc[e]; }
        if (slice < 16) {
            ssq += __shfl_xor(ssq, 1); ssq += __shfl_xor(ssq, 2); ssq += __shfl_xor(ssq, 4); ssq += __shfl_xor(ssq, 8);
            const float sc = rsqrtf(ssq + EPSF) * (slice < 8 ? 0.08838834764831845f : 1.f);
#pragma unroll
            for (int e = 0; e < 8; ++e) acc[e] *= sc;
        }
        u32x4 o; o.x = pk2(acc[0], acc[1]); o.y = pk2(acc[2], acc[3]); o.z = pk2(acc[4], acc[5]); o.w = pk2(acc[6], acc[7]);
        *(u32x4*)(colp + (row0 + (size_t)(rbase + t) * rstride) * NSCAN) = o;
    }
}
DI void phase_conv(const Params& p) {
    const int wave = threadIdx.x >> 6, lane = threadIdx.x & 63;
    bf16_t* P = (bf16_t*)(p.ws + OFF_PSCAN);
    constexpr int NLAT = NB * 64 * 24, NCT = NB * 24;
    for (int T = blockIdx.x; T < NLAT + NCT; T += gridDim.x) {
        if (T < NLAT) { const int slice = T % 24, col = (T / 24) % 64, b = T / (24 * 64);
            conv_tile<4>(P, (size_t)b * SEQ + col, 64, slice, p.gdn_conv_w, wave, lane); }
        else { const int T2 = T - NLAT, slice = T2 % 24, b = T2 / 24;
            conv_tile<8>(P, (size_t)ML + (size_t)b * CTXL, 1, slice, p.gdn_conv_w, wave, lane); }
    }
}

template <int DIR> DI int chunk_id(int st) { return DIR == 0 ? st : (st < 4 ? 3 - st : 135 - st); }
DI int gla_base(int b, int cid) { return cid < 4 ? ML + b * CTXL + 64 * cid : b * SEQ + 64 * (cid - 4); }
DI int gdn_row(int b, int cid, int i) {
    if (cid < 4) return ML + b * CTXL + 64 * cid + i;
    const int cl = cid - 4; return b * SEQ + (((cl & 1) * 64 + i) * 64) + (cl >> 1);
}
DI float wave_prefix(float v, int lane) {
    v += __builtin_bit_cast(float, __builtin_amdgcn_update_dpp(0, __builtin_bit_cast(int, v), 0x111, 0xf, 0xf, false));
    v += __builtin_bit_cast(float, __builtin_amdgcn_update_dpp(0, __builtin_bit_cast(int, v), 0x112, 0xf, 0xf, false));
    v += __builtin_bit_cast(float, __builtin_amdgcn_update_dpp(0, __builtin_bit_cast(int, v), 0x114, 0xf, 0xf, false));
    v += __builtin_bit_cast(float, __builtin_amdgcn_update_dpp(0, __builtin_bit_cast(int, v), 0x118, 0xf, 0xf, false));
    const float t0 = __shfl(v, 15), t1 = __shfl(v, 31), t2 = __shfl(v, 47);
    const int row = lane >> 4;
    return v + (row > 0 ? t0 : 0.f) + (row > 1 ? t1 : 0.f) + (row > 2 ? t2 : 0.f);
}
DI void gdn_gates(const Params& p, int dir, int h, float a, float bb, float& g2, float& beta) {
    const float A = __expf(p.gdn_a_log[dir * 8 + h]);
    g2 = -A * softplus_(a + p.gdn_dt_bias[dir * 8 + h]) * LOG2E;
    beta = sigm(bb);
}

template <int I> struct SolveRows {
    static DI void run(float (&x)[64], LAS const float* Lm, int lane) {
        float a = (lane == I) ? 1.f : 0.f;
#pragma unroll
        for (int m4 = 0; m4 < (I + 3) / 4; ++m4) {
            const f32x4 l = *(LAS const f32x4*)(Lm + I * 64 + 4 * m4);
            if (4 * m4 + 0 < I) a -= l[0] * x[4 * m4 + 0];
            if (4 * m4 + 1 < I) a -= l[1] * x[4 * m4 + 1];
            if (4 * m4 + 2 < I) a -= l[2] * x[4 * m4 + 2];
            if (4 * m4 + 3 < I) a -= l[3] * x[4 * m4 + 3];
        }
        x[I] = a;
        asm volatile("" ::: "memory");
        SolveRows<I + 1>::run(x, Lm, lane);
    }
};
template <> struct SolveRows<64> { static DI void run(float (&)[64], LAS const float*, int) {} };

DI void phase_tinv(const Params& p, LAS unsigned char* lds, int gw0, int NGW) {
    const int tid = threadIdx.x, wave = tid >> 6, lane = tid & 63, r = lane & 15, q = lane >> 4;
    const int gw = gw0 + wave;
    LAS unsigned char* kt = lds + wave * 18432; LAS float* Lm = (LAS float*)kt; LAS float* sc = (LAS float*)(kt + 17408);
    const bf16_t* P = (const bf16_t*)(p.ws + OFF_PSCAN); bf16_t* TI = (bf16_t*)(p.ws + OFF_TINV);
#pragma unroll 1
    for (int it = gw; it < NB * NCHUNK * 16; it += NGW) {
        const int dir = it & 1, h = (it >> 1) & 7, cid = (it >> 4) % NCHUNK, b = it / (16 * NCHUNK);
#pragma unroll
        for (int t = 0; t < 16; ++t) { const int i = q + 4 * t, c16 = r;
            const u32x4 v = *(const u32x4*)(P + (size_t)gdn_row(b, cid, i) * NSCAN + 3072 + 128 * h + 8 * c16);
            *(LAS u32x4*)(kt + q * 272 + 16 * c16 + t * (4 * 272)) = v; }
        {
            const bf16_t* rp = P + (size_t)gdn_row(b, cid, lane) * NSCAN + 5152 + 8 * dir + h;
            float g2, be;
            gdn_gates(p, dir, h, bf2f(rp[0]), bf2f(rp[16]), g2, be);
            const float Pf = wave_prefix(g2, lane), Tall = __shfl(Pf, 63);
            sc[lane] = dir == 0 ? Pf : Tall - Pf + g2; sc[64 + lane] = be;
        }
        lds_wait();
        f32x4 kk[4][4];
#pragma unroll
        for (int a = 0; a < 4; ++a)
#pragma unroll
            for (int c = 0; c < 4; ++c) kk[a][c] = (f32x4){0.f, 0.f, 0.f, 0.f};
#pragma unroll
        for (int ks = 0; ks < 4; ++ks) { bf16x8 fr[4];
#pragma unroll
            for (int t = 0; t < 4; ++t) fr[t] = ldsRow(kt + (16 * t + r) * 272 + 64 * ks + 16 * q);
#pragma unroll
            for (int a = 0; a < 4; ++a)
#pragma unroll
                for (int c = 0; c < 4; ++c) kk[a][c] = mfma16(fr[a], fr[c], kk[a][c]); }
        {
            float Gj[4], Bj[4];
#pragma unroll
            for (int c = 0; c < 4; ++c) { Gj[c] = sc[16 * c + r]; Bj[c] = sc[64 + 16 * c + r]; }
            LAS float* lrow = Lm + (4 * q) * 64 + r;
#pragma unroll
            for (int a = 0; a < 4; ++a) { const f32x4 g4 = *(LAS const f32x4*)(sc + 16 * a + 4 * q), b4 = *(LAS const f32x4*)(sc + 64 + 16 * a + 4 * q);
#pragma unroll
                for (int c = 0; c < 4; ++c)
#pragma unroll
                    for (int e = 0; e < 4; ++e) {
                        const int i = 16 * a + 4 * q + e, j = 16 * c + r;
                        const float dg = dir == 0 ? g4[e] - Gj[c] : Gj[c] - g4[e], be = dir == 0 ? b4[e] : Bj[c];
                        const float val = (j < i) ? be * kk[a][c][e] * ex2(fminf(dg, 0.f)) : 0.f;
                        lrow[(16 * a + e) * 64 + 16 * c] = val;
                    } }
        }
        lds_wait();
        float x[64];
        SolveRows<0>::run(x, Lm, lane);
        lds_wait();
        LAS bf16_t* img = (LAS bf16_t*)kt;
        if (dir == 0) {
#pragma unroll
            for (int i = 0; i < 64; ++i) img[i * 64 + lane] = f2bf(x[i]);
        } else {
#pragma unroll
            for (int i = 0; i < 64; ++i) img[lane * 64 + i] = f2bf(x[i]);
        }
        lds_wait();
        bf16_t* dst = TI + ((size_t)(((b * NCHUNK + cid) * 8 + h) * 2 + dir)) * 4096;
#pragma unroll
        for (int t = 0; t < 8; ++t) { const int pcs = lane + 64 * t; *(u32x4*)(dst + pcs * 8) = *(LAS const u32x4*)(kt + pcs * 16); }
        lds_wait();
    }
}

constexpr int L_Q = 0, L_K = 17408, L_V = 34816, L_A = 44032, L_SB = 53248, L_X = 71680  , L_R = 80896, L_VN = 90112, L_VD = 99328,
              L_SC = 108544  , L_SSP = 109824;

struct Pre { u32x4 q0, q1, k0, k1, v, x; unsigned pa, pb; };

template <int DIR> DI void gla_prefetch(const Params& p, int b, int h, int s, int st, Pre& R) {
    const int tid = threadIdx.x, cid = chunk_id<DIR>(st);
    const bf16_t* P = (const bf16_t*)(p.ws + OFF_PSCAN) + (size_t)gla_base(b, cid) * NSCAN;
    const int i = tid >> 4, c16 = tid & 15;
    R.q0 = *(const u32x4*)(P + (size_t)i * NSCAN + 128 * h + 8 * c16); R.q1 = *(const u32x4*)(P + (size_t)(i + 32) * NSCAN + 128 * h + 8 * c16);
    R.k0 = *(const u32x4*)(P + (size_t)i * NSCAN + 512 + 128 * h + 8 * c16); R.k1 = *(const u32x4*)(P + (size_t)(i + 32) * NSCAN + 512 + 128 * h + 8 * c16);
    R.v = *(const u32x4*)(P + (size_t)(tid >> 3) * NSCAN + 1024 + 256 * h + 64 * s + 8 * (tid & 7));
    if (tid < 128) R.x = *(const u32x4*)(P + (size_t)(tid >> 1) * NSCAN + 5120 + 16 * DIR + 8 * (tid & 1));
}
template <int DIR> DI void gdn_prefetch(const Params& p, int b, int h, int s, int st, Pre& R) {
    const int tid = threadIdx.x, cid = chunk_id<DIR>(st);
    const bf16_t* P = (const bf16_t*)(p.ws + OFF_PSCAN);
    const int i = tid >> 4, c16 = tid & 15;
    const size_t r0 = (size_t)gdn_row(b, cid, i) * NSCAN, r1 = (size_t)gdn_row(b, cid, i + 32) * NSCAN;
    R.q0 = *(const u32x4*)(P + r0 + 2048 + 128 * h + 8 * c16); R.q1 = *(const u32x4*)(P + r1 + 2048 + 128 * h + 8 * c16);
    R.k0 = *(const u32x4*)(P + r0 + 3072 + 128 * h + 8 * c16); R.k1 = *(const u32x4*)(P + r1 + 3072 + 128 * h + 8 * c16);
    R.v = *(const u32x4*)(P + (size_t)gdn_row(b, cid, tid >> 3) * NSCAN + 4096 + 128 * h + 64 * s + 8 * (tid & 7));
    const bf16_t* TI = (const bf16_t*)(p.ws + OFF_TINV) + ((size_t)(((b * NCHUNK + cid) * 8 + h) * 2 + DIR)) * 4096;
    R.x = *(const u32x4*)(TI + tid * 8);
    if (tid < 64) { const bf16_t* rp = P + (size_t)gdn_row(b, cid, tid) * NSCAN + 5152 + 8 * DIR + h; R.pa = rp[0]; R.pb = rp[16]; }
}
DI void scan_stage0_common(LAS unsigned char* lds, const Pre& R, const f32x4 (&S)[4]) {
    const int tid = threadIdx.x, w = tid >> 6, lane = tid & 63, r = lane & 15, q = lane >> 4;
    const int i = tid >> 4, c16 = tid & 15;
    *(LAS u32x4*)(lds + L_Q + i * 272 + 16 * c16) = R.q0; *(LAS u32x4*)(lds + L_Q + (i + 32) * 272 + 16 * c16) = R.q1;
    *(LAS u32x4*)(lds + L_K + i * 272 + 16 * c16) = R.k0; *(LAS u32x4*)(lds + L_K + (i + 32) * 272 + 16 * c16) = R.k1;
    *(LAS u32x4*)(lds + L_V + (tid >> 3) * 144 + 16 * (tid & 7)) = R.v;
    const int dvt = w & 3, dh = w >> 2;
#pragma unroll
    for (int t = 0; t < 4; ++t) { const int d = 16 * (4 * dh + t) + r; *(LAS u32x2*)(lds + L_SB + d * 144 + (16 * dvt + 4 * q) * 2) = pack4(S[t]); }
}
DI void scan_out(bf16_t* op, f32x4 o, bool second, const u32x2 prev, LAS float* SSP, int i, int dvt, int q) {
    if (second) { o[0] += bflo(prev.x); o[1] += bfhi(prev.x); o[2] += bflo(prev.y); o[3] += bfhi(prev.y); }
    const u32x2 pk = pack4(o);
    *(u32x2*)op = pk;
    if (second) {
        const float a0 = bflo(pk.x), a1 = bfhi(pk.x), a2 = bflo(pk.y), a3 = bfhi(pk.y);
        float ssq = (a0 * a0 + a1 * a1) + (a2 * a2 + a3 * a3);
        ssq += __shfl_xor(ssq, 16); ssq += __shfl_xor(ssq, 32);
        if (q == 0) SSP[i * 4 + dvt] = ssq;
    }
}

template <int DIR> DI void gla_step(const Params& p, LAS unsigned char* lds, int b, int h, int s, int st, f32x4 (&S)[4], const bf16x8 lrw, const f32x4 lrbias, Pre& R) {
    const int tid = threadIdx.x, w = tid >> 6, lane = tid & 63, r = lane & 15, q = lane >> 4;
    const int cid = chunk_id<DIR>(st); const bool latent = cid >= 4; const int base = gla_base(b, cid);
    const bool second = latent && (DIR == 0 ? (cid - 4 >= 64) : (cid - 4 <= 63));
    LAS float* EG = (LAS float*)(lds + L_SC); LAS float* SSP = (LAS float*)(lds + L_SSP);
    const int dvt = w & 3, ih = w >> 2;
    bf16_t* const ob = (bf16_t*)p.out;
    u32x2 prev[2] = {{0u, 0u}, {0u, 0u}};
    if (second) {
#pragma unroll
        for (int u = 0; u < 2; ++u) prev[u] = *(const u32x2*)(ob + (size_t)(base + 16 * (2 * ih + u) + r) * 2048 + 256 * h + 64 * s + 16 * dvt + 4 * q);
    }
    scan_stage0_common(lds, R, S);
    if (tid < 128) *(LAS u32x4*)(lds + L_X + (tid >> 1) * 80 + 16 * (tid & 1)) = R.x;
    lds_barrier();
    if (DIR == 0) gla_prefetch<1>(p, b, h, s, st, R); else if (st + 1 < NCHUNK) gla_prefetch<0>(p, b, h, s, st + 1, R);
    {
        float g[4][4], Pfx[4][4], run[4] = {0.f, 0.f, 0.f, 0.f};
        const f32x4 zero = {0.f, 0.f, 0.f, 0.f};
        const int d0 = 16 * w + 4 * q;
#pragma unroll
        for (int t = 0; t < 4; ++t) {
            bf16x8 xf = {0, 0, 0, 0, 0, 0, 0, 0};
            if (q < 2) xf = ldsRow(lds + L_X + (16 * t + r) * 80 + 16 * q);
            const f32x4 z = mfma16(lrw, xf, zero);
#pragma unroll
            for (int j = 0; j < 4; ++j) { const float zz = z[j] + lrbias[j];
                g[t][j] = (fminf(zz, 0.f) * LOG2E - lg2(1.f + ex2(-LOG2E * fabsf(zz)))) * 0.0625f; }
        }
        u32x2 qv[4], kv[4];
#pragma unroll
        for (int t = 0; t < 4; ++t) { const int off = (16 * t + r) * 272 + 2 * d0; qv[t] = *(LAS const u32x2*)(lds + L_Q + off); kv[t] = *(LAS const u32x2*)(lds + L_K + off); }
#pragma unroll
        for (int t = 0; t < 4; ++t) {
#pragma unroll
            for (int j = 0; j < 4; ++j) {
                float v = g[t][j];
                v += __builtin_bit_cast(float, __builtin_amdgcn_update_dpp(0, __builtin_bit_cast(int, v), 0x111, 0xf, 0xf, false));
                v += __builtin_bit_cast(float, __builtin_amdgcn_update_dpp(0, __builtin_bit_cast(int, v), 0x112, 0xf, 0xf, false));
                v += __builtin_bit_cast(float, __builtin_amdgcn_update_dpp(0, __builtin_bit_cast(int, v), 0x114, 0xf, 0xf, false));
                v += __builtin_bit_cast(float, __builtin_amdgcn_update_dpp(0, __builtin_bit_cast(int, v), 0x118, 0xf, 0xf, false));
                Pfx[t][j] = run[j] + v;
                run[j] += __shfl(v, (lane & 48) | 15);
            }
        }
#pragma unroll
        for (int t = 0; t < 4; ++t) {
            float eq[4], ek[4];
#pragma unroll
            for (int j = 0; j < 4; ++j) { const float G = DIR == 0 ? Pfx[t][j] : run[j] - Pfx[t][j] + g[t][j]; eq[j] = ex2(G) * 0.08838834764831845f; ek[j] = ex2(-G); }
            u32x2 qo, ko;
            qo.x = pk2(bflo(qv[t].x) * eq[0], bfhi(qv[t].x) * eq[1]); qo.y = pk2(bflo(qv[t].y) * eq[2], bfhi(qv[t].y) * eq[3]);
            ko.x = pk2(bflo(kv[t].x) * ek[0], bfhi(kv[t].x) * ek[1]); ko.y = pk2(bflo(kv[t].y) * ek[2], bfhi(kv[t].y) * ek[3]);
            const int off = (16 * t + r) * 272 + 2 * d0;
            *(LAS u32x2*)(lds + L_Q + off) = qo; *(LAS u32x2*)(lds + L_K + off) = ko;
        }
        if (r == 0) { f32x4 e4; e4[0] = ex2(run[0]); e4[1] = ex2(run[1]); e4[2] = ex2(run[2]); e4[3] = ex2(run[3]); *(LAS f32x4*)(EG + d0) = e4; }
    }
    lds_barrier();
    if (latent) {
        const int it2 = w >> 1;
#pragma unroll
        for (int jj = 0; jj < 2; ++jj) {
            const int jt = 2 * (w & 1) + jj; const bool act = DIR == 0 ? (jt <= it2) : (jt >= it2);
            f32x4 acc = {0.f, 0.f, 0.f, 0.f};
            if (act) {
                bf16x8 fk[4], fq[4];
#pragma unroll
                for (int ks = 0; ks < 4; ++ks) { fk[ks] = ldsRow(lds + L_K + (16 * jt + r) * 272 + 64 * ks + 16 * q); fq[ks] = ldsRow(lds + L_Q + (16 * it2 + r) * 272 + 64 * ks + 16 * q); }
#pragma unroll
                for (int ks = 0; ks < 4; ++ks) acc = mfma16(fk[ks], fq[ks], acc);
            }
            const int i = 16 * it2 + r;
#pragma unroll
            for (int e = 0; e < 4; ++e) { const int j = 16 * jt + 4 * q + e; const bool keep = DIR == 0 ? (j <= i) : (j >= i); acc[e] = keep ? acc[e] : 0.f; }
            *(LAS u32x2*)(lds + L_A + i * 144 + (16 * jt + 4 * q) * 2) = pack4(acc);
        }
        lds_barrier();
        f32x4 o[2] = {{0.f, 0.f, 0.f, 0.f}, {0.f, 0.f, 0.f, 0.f}};
        {
            bf16x8 X[6], Y[6][2];
#pragma unroll
            for (int ks = 0; ks < 2; ++ks) { X[ks] = ldsT(lds + L_V, 144, 32 * ks, 16 * dvt, lane);
#pragma unroll
                for (int u = 0; u < 2; ++u) Y[ks][u] = ldsRow(lds + L_A + (16 * (2 * ih + u) + r) * 144 + 64 * ks + 16 * q); }
#pragma unroll
            for (int ks = 0; ks < 4; ++ks) { X[2 + ks] = ldsT(lds + L_SB, 144, 32 * ks, 16 * dvt, lane);
#pragma unroll
                for (int u = 0; u < 2; ++u) Y[2 + ks][u] = ldsRow(lds + L_Q + (16 * (2 * ih + u) + r) * 272 + 64 * ks + 16 * q); }
#pragma unroll
            for (int kk = 0; kk < 6; ++kk)
#pragma unroll
                for (int u = 0; u < 2; ++u) o[u] = mfma16(X[kk], Y[kk][u], o[u]);
        }
#pragma unroll
        for (int u = 0; u < 2; ++u) { const int i = 16 * (2 * ih + u) + r;
            scan_out(ob + (size_t)(base + i) * 2048 + 256 * h + 64 * s + 16 * dvt + 4 * q, o[u], second, prev[u], SSP, i, dvt, q); }
    }
    {
        bf16x8 X[2], Y[2][4];
#pragma unroll
        for (int ks = 0; ks < 2; ++ks) { X[ks] = ldsT(lds + L_V, 144, 32 * ks, 16 * dvt, lane);
#pragma unroll
            for (int t = 0; t < 4; ++t) Y[ks][t] = ldsT(lds + L_K, 272, 32 * ks, 16 * (4 * ih + t), lane); }
#pragma unroll
        for (int ks = 0; ks < 2; ++ks)
#pragma unroll
            for (int t = 0; t < 4; ++t) S[t] = mfma16(X[ks], Y[ks][t], S[t]);
    }
#pragma unroll
    for (int t = 0; t < 4; ++t) { const float eg = EG[16 * (4 * ih + t) + r]; S[t] = S[t] * eg; }
    lds_barrier();
    if (second && tid < 64) { const f32x4 s4 = *(LAS const f32x4*)(SSP + 4 * tid);
        ((float*)(p.ws + OFF_SS))[(size_t)(base + tid) * 32 + 4 * h + s] = (s4[0] + s4[1]) + (s4[2] + s4[3]); }
}

template <int DIR> DI void gdn_step(const Params& p, LAS unsigned char* lds, int b, int h, int s, int st, f32x4 (&S)[4], Pre& R, const float gA, const float gDt) {
    const int tid = threadIdx.x, w = tid >> 6, lane = tid & 63, r = lane & 15, q = lane >> 4;
    const int cid = chunk_id<DIR>(st); const bool latent = cid >= 4;
    const bool second = latent && (DIR == 0 ? (cid - 4 >= 64) : (cid - 4 <= 63));
    LAS float* sG = (LAS float*)(lds + L_SC); LAS float* sEG = sG + 64; LAS float* sBeta = sG + 128; LAS float* sEdec = sG + 192; LAS float* sEGend = sG + 256;
    LAS float* SSP = (LAS float*)(lds + L_SSP);
    const int dvt = w & 3, ih = w >> 2;
    bf16_t* const ob = (bf16_t*)p.out;
    u32x2 prev[2] = {{0u, 0u}, {0u, 0u}};
    if (second) {
#pragma unroll
        for (int u = 0; u < 2; ++u) prev[u] = *(const u32x2*)(ob + (size_t)gdn_row(b, cid, 16 * (2 * ih + u) + r) * 2048 + 1024 + 128 * h + 64 * s + 16 * dvt + 4 * q);
    }
    scan_stage0_common(lds, R, S);
    *(LAS u32x4*)(lds + L_X + (tid >> 3) * 144 + 16 * (tid & 7)) = R.x;
    if (tid < 64) {
        const float g2 = -gA * softplus_(bf2f((bf16_t)R.pa) + gDt) * LOG2E, beta = sigm(bf2f((bf16_t)R.pb));
        const float Pf = wave_prefix(g2, lane), Tall = __shfl(Pf, 63);
        const float G = DIR == 0 ? Pf : Tall - Pf + g2;
        sG[lane] = G; sEG[lane] = ex2(G); sBeta[lane] = beta; sEdec[lane] = ex2(Tall - G); if (lane == 0) sEGend[0] = ex2(Tall);
    }
    lds_barrier();
    if (DIR == 0) gdn_prefetch<1>(p, b, h, s, st, R); else if (st + 1 < NCHUNK) gdn_prefetch<0>(p, b, h, s, st + 1, R);
    {
        f32x4 pa[2] = {{0.f, 0.f, 0.f, 0.f}, {0.f, 0.f, 0.f, 0.f}};
        {
            bf16x8 X[4], Y[4][2];
#pragma unroll
            for (int ks = 0; ks < 4; ++ks) { X[ks] = ldsT(lds + L_SB, 144, 32 * ks, 16 * dvt, lane);
#pragma unroll
                for (int u = 0; u < 2; ++u) Y[ks][u] = ldsRow(lds + L_K + (16 * (2 * ih + u) + r) * 272 + 64 * ks + 16 * q); }
#pragma unroll
            for (int ks = 0; ks < 4; ++ks)
#pragma unroll
                for (int u = 0; u < 2; ++u) pa[u] = mfma16(X[ks], Y[ks][u], pa[u]);
        }
#pragma unroll
        for (int u = 0; u < 2; ++u) { const int i = 16 * (2 * ih + u) + r; const float eg = sEG[i], be = sBeta[i];
            const u32x2 vv = *(LAS const u32x2*)(lds + L_V + i * 144 + (16 * dvt + 4 * q) * 2);
            f32x4 rr; rr[0] = be * (bflo(vv.x) - eg * pa[u][0]); rr[1] = be * (bfhi(vv.x) - eg * pa[u][1]); rr[2] = be * (bflo(vv.y) - eg * pa[u][2]); rr[3] = be * (bfhi(vv.y) - eg * pa[u][3]);
            *(LAS u32x2*)(lds + L_R + i * 144 + (16 * dvt + 4 * q) * 2) = pack4(rr); }
    }
    if (latent) {
        const int it2 = w >> 1;
#pragma unroll
        for (int jj = 0; jj < 2; ++jj) {
            const int jt = 2 * (w & 1) + jj; const bool act = DIR == 0 ? (jt <= it2) : (jt >= it2);
            f32x4 acc = {0.f, 0.f, 0.f, 0.f};
            if (act) {
                bf16x8 fk[4], fq[4];
#pragma unroll
                for (int ks = 0; ks < 4; ++ks) { fk[ks] = ldsRow(lds + L_K + (16 * jt + r) * 272 + 64 * ks + 16 * q); fq[ks] = ldsRow(lds + L_Q + (16 * it2 + r) * 272 + 64 * ks + 16 * q); }
#pragma unroll
                for (int ks = 0; ks < 4; ++ks) acc = mfma16(fk[ks], fq[ks], acc);
            }
            const int i = 16 * it2 + r; const float Gi = sG[i]; const f32x4 Gj = *(LAS const f32x4*)(sG + 16 * jt + 4 * q);
#pragma unroll
            for (int e = 0; e < 4; ++e) { const int j = 16 * jt + 4 * q + e; const bool keep = DIR == 0 ? (j <= i) : (j >= i); acc[e] = keep ? acc[e] * ex2(fminf(Gi - Gj[e], 0.f)) : 0.f; }
            *(LAS u32x2*)(lds + L_A + i * 144 + (16 * jt + 4 * q) * 2) = pack4(acc);
        }
    }
    lds_barrier();
    {
        f32x4 va[2] = {{0.f, 0.f, 0.f, 0.f}, {0.f, 0.f, 0.f, 0.f}};
        {
            bf16x8 X[2], Y[2][2];
#pragma unroll
            for (int ks = 0; ks < 2; ++ks) { X[ks] = ldsT(lds + L_R, 144, 32 * ks, 16 * dvt, lane);
#pragma unroll
                for (int u = 0; u < 2; ++u) Y[ks][u] = ldsRow(lds + L_X + (16 * (2 * ih + u) + r) * 144 + 64 * ks + 16 * q); }
#pragma unroll
            for (int ks = 0; ks < 2; ++ks)
#pragma unroll
                for (int u = 0; u < 2; ++u) va[u] = mfma16(X[ks], Y[ks][u], va[u]);
        }
#pragma unroll
        for (int u = 0; u < 2; ++u) { const int i = 16 * (2 * ih + u) + r; const float ed = sEdec[i];
            *(LAS u32x2*)(lds + L_VN + i * 144 + (16 * dvt + 4 * q) * 2) = pack4(va[u]);
            *(LAS u32x2*)(lds + L_VD + i * 144 + (16 * dvt + 4 * q) * 2) = pack4(va[u] * ed); }
    }
    lds_barrier();
    if (latent) {
        f32x4 o[2] = {{0.f, 0.f, 0.f, 0.f}, {0.f, 0.f, 0.f, 0.f}};
        {
            bf16x8 X[6], Y[6][2]; float egs[2];
#pragma unroll
            for (int ks = 0; ks < 4; ++ks) { X[ks] = ldsT(lds + L_SB, 144, 32 * ks, 16 * dvt, lane);
#pragma unroll
                for (int u = 0; u < 2; ++u) Y[ks][u] = ldsRow(lds + L_Q + (16 * (2 * ih + u) + r) * 272 + 64 * ks + 16 * q); }
#pragma unroll
            for (int ks = 0; ks < 2; ++ks) { X[4 + ks] = ldsT(lds + L_VN, 144, 32 * ks, 16 * dvt, lane);
#pragma unroll
                for (int u = 0; u < 2; ++u) Y[4 + ks][u] = ldsRow(lds + L_A + (16 * (2 * ih + u) + r) * 144 + 64 * ks + 16 * q); }
#pragma unroll
            for (int u = 0; u < 2; ++u) egs[u] = sEG[16 * (2 * ih + u) + r];
#pragma unroll
            for (int ks = 0; ks < 4; ++ks)
#pragma unroll
                for (int u = 0; u < 2; ++u) o[u] = mfma16(X[ks], Y[ks][u], o[u]);
#pragma unroll
            for (int u = 0; u < 2; ++u) o[u] = o[u] * egs[u];
#pragma unroll
            for (int ks = 4; ks < 6; ++ks)
#pragma unroll
                for (int u = 0; u < 2; ++u) o[u] = mfma16(X[ks], Y[ks][u], o[u]);
        }
#pragma unroll
        for (int u = 0; u < 2; ++u) { const int i = 16 * (2 * ih + u) + r;
            scan_out(ob + (size_t)gdn_row(b, cid, i) * 2048 + 1024 + 128 * h + 64 * s + 16 * dvt + 4 * q, o[u], second, prev[u], SSP, i, dvt, q); }
    }
    {
        const float eg = sEGend[0];
#pragma unroll
        for (int t = 0; t < 4; ++t) S[t] = S[t] * eg;
        bf16x8 X[2], Y[2][4];
#pragma unroll
        for (int ks = 0; ks < 2; ++ks) { X[ks] = ldsT(lds + L_VD, 144, 32 * ks, 16 * dvt, lane);
#pragma unroll
            for (int t = 0; t < 4; ++t) Y[ks][t] = ldsT(lds + L_K, 272, 32 * ks, 16 * (4 * ih + t), lane); }
#pragma unroll
        for (int ks = 0; ks < 2; ++ks)
#pragma unroll
            for (int t = 0; t < 4; ++t) S[t] = mfma16(X[ks], Y[ks][t], S[t]);
    }
    lds_barrier();
    if (second && tid < 64) { const f32x4 s4 = *(LAS const f32x4*)(SSP + 4 * tid);
        ((float*)(p.ws + OFF_SS))[(size_t)gdn_row(b, cid, tid) * 32 + 16 + 2 * h + s] = (s4[0] + s4[1]) + (s4[2] + s4[3]); }
}

DI void phase_scan(const Params& p, LAS unsigned char* lds) {
    const int tid = threadIdx.x, w = tid >> 6, lane = tid & 63, r = lane & 15, q = lane >> 4;
    if (gridDim.x == 256 && ((blockIdx.x >> 3) >= 16)) {
        const int xcd0 = blockIdx.x & 7, idx0 = blockIdx.x >> 3, rr = ((xcd0 * 8 + ((idx0 - 16) >> 1)) << 1) | (idx0 & 1);
        phase_tinv(p, lds, rr * 8, 1024);
        __syncthreads();
        if (tid == 0) {
            unsigned* ctr = (unsigned*)(p.ws + OFF_CTR);
            __threadfence();
            __hip_atomic_fetch_add(ctr, 1u, __ATOMIC_RELAXED, __HIP_MEMORY_SCOPE_AGENT);
            while (__hip_atomic_load(ctr, __ATOMIC_RELAXED, __HIP_MEMORY_SCOPE_AGENT) < 128u) __builtin_amdgcn_s_sleep(16);
            __threadfence();
        }
        __syncthreads();
    }
    for (int role0 = blockIdx.x; role0 < 256; role0 += gridDim.x) {
        int role = role0;
        if (gridDim.x == 256) { const int xcd = role0 & 7, idx = role0 >> 3; role = idx < 16 ? ((xcd * 4 + (idx >> 2)) << 2) | (idx & 3) : 128 + (((xcd * 8 + ((idx - 16) >> 1)) << 1) | (idx & 1)); }
        f32x4 Sf[4], Sb[4];
#pragma unroll
        for (int t = 0; t < 4; ++t) { Sf[t] = (f32x4){0.f, 0.f, 0.f, 0.f}; Sb[t] = (f32x4){0.f, 0.f, 0.f, 0.f}; }
        Pre R; R.q0 = R.q1 = R.k0 = R.k1 = R.v = R.x = (u32x4){0u, 0u, 0u, 0u}; R.pa = R.pb = 0u;
        __syncthreads();
        if (role < 128) {
            const int b = role >> 4, h = (role >> 2) & 3, s = role & 3;
            bf16x8 lw0 = {0, 0, 0, 0, 0, 0, 0, 0}, lw1 = {0, 0, 0, 0, 0, 0, 0, 0};
            const int d = 128 * h + 16 * w + r;
            if (q < 2) {
#pragma unroll
                for (int e = 0; e < 8; ++e) { lw0[e] = (short)f2bf(p.gla_lr_w[(size_t)(8 * q + e) * 512 + d]); lw1[e] = (short)f2bf(p.gla_lr_w[(size_t)(16 + 8 * q + e) * 512 + d]); }
            }
            const f32x4 lb0 = *(const f32x4*)(p.gla_lr_b + 128 * h + 16 * w + 4 * q), lb1 = *(const f32x4*)(p.gla_lr_b + 512 + 128 * h + 16 * w + 4 * q);
            gla_prefetch<0>(p, b, h, s, 0, R);
#pragma unroll 1
            for (int st = 0; st < NCHUNK; ++st) { gla_step<0>(p, lds, b, h, s, st, Sf, lw0, lb0, R); gla_step<1>(p, lds, b, h, s, st, Sb, lw1, lb1, R); }
        } else {
            const int rr = role - 128, b = rr >> 4, h = (rr >> 1) & 7, s = rr & 1;
            const float gA0 = __expf(p.gdn_a_log[h]), gA1 = __expf(p.gdn_a_log[8 + h]), gD0 = p.gdn_dt_bias[h], gD1 = p.gdn_dt_bias[8 + h];
            gdn_prefetch<0>(p, b, h, s, 0, R);
#pragma unroll 1
            for (int st = 0; st < NCHUNK; ++st) { gdn_step<0>(p, lds, b, h, s, st, Sf, R, gA0, gD0); gdn_step<1>(p, lds, b, h, s, st, Sb, R, gA1, gD1); }
        }
    }
}

#define XB_TMO      128
#define XB_XCNT(j)  (256  + 64 * (j))
#define XB_XSUB(j)  (1280 + 64 * (j))
#define XB_XGEN(j)  (2304 + 64 * (j))
#define XB_TOP      3328
#define XB_TOPGEN   3392
#define XCD_BAR_WORDS 3456
#define XB_SPIN_CAP (1u << 18)

__device__ __forceinline__ unsigned xb_ld(unsigned* p)              { return __hip_atomic_load(p, __ATOMIC_RELAXED, __HIP_MEMORY_SCOPE_AGENT); }
__device__ __forceinline__ unsigned xb_add(unsigned* p, unsigned v) { return __hip_atomic_fetch_add(p, v, __ATOMIC_RELAXED, __HIP_MEMORY_SCOPE_AGENT); }
__device__ __forceinline__ unsigned xb_xcc_id() { return (unsigned)__builtin_amdgcn_s_getreg((3 << 11) | 20) & 0xFu; }
#define XB_SPIN(cond, bar) do { unsigned _sp = 0; while (cond) { __builtin_amdgcn_s_sleep(1); \
    if ((++_sp & 255u) == 0u) { if (xb_ld(&(bar)[XB_TMO])) break; if (_sp > XB_SPIN_CAP) { atomicAdd(&(bar)[XB_TMO], 1u); break; } } } } while (0)

struct XcdBarrier {
    unsigned* bar; unsigned x;
    volatile LAS unsigned* st;
};

__device__ __forceinline__ XcdBarrier xcd_barrier_post(unsigned* bar, volatile LAS unsigned* st) {
    XcdBarrier b; b.bar = bar; b.x = xb_xcc_id(); b.st = st;
    if (threadIdx.x == 0) (void)xb_add(&bar[XB_XCNT(b.x)], 1u);
    return b;
}
__device__ __forceinline__ void xcd_barrier_complete(unsigned* bar, unsigned x, unsigned& nloc, unsigned& nx) {
    const unsigned G = gridDim.x * gridDim.y * gridDim.z;
    unsigned sum, cnt, mine, sp = 0u;
    for (;;) {
        sum = 0u; cnt = 0u; mine = 0u;
#pragma unroll
        for (unsigned j = 0; j < 16; ++j) { const unsigned c = xb_ld(&bar[XB_XCNT(j)]); sum += c; cnt += (c > 0u) ? 1u : 0u; mine = (j == x) ? c : mine; }
        if (sum == G) break;
        __builtin_amdgcn_s_sleep(1);
        if ((++sp & 255u) == 0u) { if (xb_ld(&bar[XB_TMO])) break; if (sp > XB_SPIN_CAP) { atomicAdd(&bar[XB_TMO], 1u); break; } }
    }
    nloc = mine > 0u ? mine : 1u; nx = cnt > 0u ? cnt : 1u;
}

__device__ __forceinline__ void xcd_barrier(const XcdBarrier& b) {
    asm volatile("s_waitcnt vmcnt(0)" ::: "memory");
    __syncthreads();
    if (threadIdx.x == 0) {
        unsigned* bar = b.bar;
        __builtin_amdgcn_s_waitcnt(0);
        unsigned nloc = b.st[0], nx = b.st[1];
        if (nloc == 0u) { xcd_barrier_complete(bar, b.x, nloc, nx); b.st[0] = nloc; b.st[1] = nx; }
        const unsigned old = xb_add(&bar[XB_XSUB(b.x)], 1u);
        const unsigned gen = old / nloc;
        if (old + 1u == (gen + 1u) * nloc) {
            __builtin_amdgcn_fence(__ATOMIC_RELEASE, "agent");
            asm volatile("s_waitcnt vmcnt(0)" ::: "memory");
            const unsigned og = xb_add(&bar[XB_TOP], 1u);
            const unsigned tg = og / nx;
            if (og + 1u == (tg + 1u) * nx) xb_add(&bar[XB_TOPGEN], 1u);
            else XB_SPIN(xb_ld(&bar[XB_TOPGEN]) == tg, bar);
            __builtin_amdgcn_fence(__ATOMIC_ACQUIRE, "agent");
            xb_add(&bar[XB_XGEN(b.x)], 1u);
            asm volatile("s_waitcnt vmcnt(0)" ::: "memory");
        } else {
            XB_SPIN(xb_ld(&bar[XB_XGEN(b.x)]) == gen, bar);
            __builtin_amdgcn_fence(__ATOMIC_ACQUIRE, "agent");
            asm volatile("s_waitcnt vmcnt(0)" ::: "memory");
        }
    }
    __syncthreads();
}

__global__ __launch_bounds__(512, 2) void mega(Params p) {
    extern __shared__ __attribute__((aligned(16))) unsigned char smem[];
    LAS unsigned char* lds = (LAS unsigned char*)smem;
    const int lo = p.ph_lo, hi = p.ph_hi;
#ifndef ONLY_PHASE
#define ONLY_PHASE -1
#endif
#define IN(k) ((ONLY_PHASE < 0 || ONLY_PHASE == (k)) && lo <= (k) && (k) < hi)
#define SEAM(k) do { if (IN(k) && IN((k) + 1)) xcd_barrier(xb); } while (0)
    volatile LAS unsigned* xst = (volatile LAS unsigned*)(lds + LDS_XB);
    if (threadIdx.x == 0) { xst[0] = 0u; xst[1] = 0u; }
    __syncthreads();
    const XcdBarrier xb = xcd_barrier_post((unsigned*)(p.ws + OFF_XBAR), xst);
    if (lo == -12345) cg::this_grid().sync();
    const int G = gridDim.x, c = blockIdx.x;
    if (IN(0)) phase0(p, lds);
    SEAM(0);
    if (IN(1)) phase_hn(p);
    SEAM(1);
    if (IN(2)) { pg8::Gemm g{(const bf16_t*)(p.ws + OFF_HN), (const bf16_t*)(p.ws + OFF_WSCAN), MALL, NSCAN_PAD, DM}; pg8::StaticOrder S; S.init(MALL, NSCAN_PAD, G, c);
        EpiScan E{(bf16_t*)(p.ws + OFF_PSCAN)}; pg8::gemm_phase<EpiScan, pg8::StaticOrder, GEMM_ALIGN, GEMM_SP2>(lds, g, S, E); }
    SEAM(2);
    if (IN(3)) phase_conv(p);
    SEAM(3);
    if (IN(4) && gridDim.x != 256) phase_tinv(p, lds, blockIdx.x * 8, gridDim.x * 8);
    if (gridDim.x != 256) SEAM(4);
    if (IN(5)) phase_scan(p, lds);
    SEAM(5);
    if (IN(6)) { pg8::Gemm g{(const bf16_t*)(p.ws + OFF_HN), (const bf16_t*)(p.ws + OFF_WMERGE), ML, NMERGE, DM}; pg8::StaticOrder S; S.init(ML, NMERGE, G, c);
        EpiMerge E{(const bf16_t*)p.out, (const float*)(p.ws + OFF_SS), p.gla_norm_w, p.gdn_norm_w, (bf16_t*)(p.ws + OFF_M)};
        pg8::gemm_phase<EpiMerge, pg8::StaticOrder, GEMM_ALIGN, GEMM_SP2>(lds, g, S, E); }
    SEAM(6);
    if (IN(7)) { pg8::Gemm g{(const bf16_t*)(p.ws + OFF_M), (const bf16_t*)(p.ws + OFF_WOUT), ML, DM, DM}; pg8::StaticOrder S; S.init(ML, DM, G, c);
        EpiY E{(const float*)(p.ws + OFF_MOD) + 2048, (bf16_t*)(p.ws + OFF_Y1)}; pg8::gemm_phase<EpiY, pg8::StaticOrder, GEMM_ALIGN, GEMM_SP2>(lds, g, S, E); }
    SEAM(7);
    if (IN(8)) phase_hn2(p);
    SEAM(8);
    if (IN(9)) { pg8::Gemm g{(const bf16_t*)(p.ws + OFF_HN), (const bf16_t*)(p.ws + OFF_WGU), ML, NGU, DM}; pg8::StaticOrder S; S.init(ML, NGU, G, c);
        EpiGU E{(bf16_t*)(p.ws + OFF_H)}; pg8::gemm_phase<EpiGU, pg8::StaticOrder, GEMM_ALIGN, GEMM_SP2>(lds, g, S, E); }
    SEAM(9);
    if (IN(10)) { pg8::Gemm g{(const bf16_t*)(p.ws + OFF_H), (const bf16_t*)(p.ws + OFF_WD), ML, DM, FFN}; pg8::StaticOrder S; S.init(ML, DM, G, c);
        EpiY E{(const float*)(p.ws + OFF_MOD) + 5120, (bf16_t*)(p.ws + OFF_Y2)}; pg8::gemm_phase<EpiY, pg8::StaticOrder, GEMM_ALIGN, GEMM_SP2>(lds, g, S, E); }
    SEAM(10);
    if (IN(11)) phase_final(p);
#undef IN
#undef SEAM
}

extern "C" void kernel_launch(void* const* d_in, const int* in_sizes, int n_in, void* d_out, int out_size, void* d_ws, size_t ws_size, hipStream_t stream) {
    static int grid = 0;
    if (grid == 0) {
        if (n_in != 21 || out_size != ML * DM || ws_size < WS_END + 4096 + 16384) { fprintf(stderr, "kernel_launch: unexpected shapes (n_in %d out %d ws %zu need %zu)\n", n_in, out_size, ws_size, (size_t)WS_END); grid = -1; return; }
        int dev = 0, cus = 0, per_cu = 0;
        hipGetDevice(&dev); hipDeviceGetAttribute(&cus, hipDeviceAttributeMultiprocessorCount, dev);
        if (hipFuncSetAttribute((const void*)mega, hipFuncAttributeMaxDynamicSharedMemorySize, LDS_BYTES) != hipSuccess) { fprintf(stderr, "kernel_launch: hipFuncSetAttribute failed\n"); grid = -1; return; }
        if (hipOccupancyMaxActiveBlocksPerMultiprocessor(&per_cu, (const void*)mega, 512, LDS_BYTES) != hipSuccess || per_cu < 1) { fprintf(stderr, "kernel_launch: occupancy query gave %d\n", per_cu); per_cu = 1; }
        (void)hipGetLastError();
        grid = cus * per_cu;
    }
    if (grid < 0) return;
    (void)hipMemsetAsync((unsigned char*)d_ws + OFF_XBAR, 0, XCD_BAR_WORDS * 4, stream);
    Params p{};
    const float** pp = (const float**)&p;
    for (int i = 0; i < 21; ++i) pp[i] = (const float*)d_in[i];
    p.out = (float*)d_out; p.ws = (unsigned char*)d_ws;
#if N_LAUNCHES == 1
    p.ph_lo = 0; p.ph_hi = NPHASE;
    void* args[] = {&p};
    hipError_t e = hipLaunchCooperativeKernel((const void*)mega, dim3(grid), dim3(512), args, LDS_BYTES, stream);
    if (e != hipSuccess) fprintf(stderr, "kernel_launch: cooperative launch failed: %s (grid %d)\n", hipGetErrorString(e), grid);
#else
    for (int k = 0; k < NPHASE; ++k) { p.ph_lo = k; p.ph_hi = k + 1; hipLaunchKernelGGL(mega, dim3(grid), dim3(512), LDS_BYTES, stream, p); }
#endif
}
```

```cpp
#include <hip/hip_runtime.h>
#include <hip/hip_cooperative_groups.h>
#include <cstdio>
#include <cstdint>
namespace pg8 {
#define PG8_LAS __attribute__((address_space(3)))
typedef unsigned short bf16_t;
typedef short bf16x8 __attribute__((ext_vector_type(8)));
typedef float f32x4 __attribute__((ext_vector_type(4)));
typedef unsigned u32x4 __attribute__((ext_vector_type(4)));
constexpr int BM = 256, BK = 64, HALF = 128, HTB = HALF * BK * 2  , STAGE_BYTES = 8 * HTB, NXCD = 8, WGM = 8;

__host__ __device__ __forceinline__ int lds_byte(int r, int c) { const int st = (r >> 4) * 2 + (c >> 5), rr = r & 15, cc = c & 31, ob = rr * 64 + cc * 2; return st * 1024 + (ob ^ (((ob >> 9) & 1) << 5)); }
__host__ __device__ __forceinline__ void stage_rc(int b, int& R, int& C) { const int st = b / 1024, sb = b % 1024, swz = sb ^ (((sb >> 9) & 1) << 5); R = (st >> 1) * 16 + swz / 64; C = (st & 1) * 32 + (swz % 64) / 2; }
__host__ __device__ __forceinline__ int perm32(int rho) { const int n = rho >> 4, i = rho & 15; return 8 * (i >> 2) + 4 * n + (i & 3); }

struct Unit { int pm, pn; };
struct Gemm { const bf16_t* A; const bf16_t* Bt; int M, N, K; };

struct StaticOrder {
    int nM, nN, nwg, G, c;
    __host__ __device__ void init(int M, int N, int G_, int c_) { nM = M / BM; nN = N / BM; nwg = nM * nN; G = G_; c = c_; }
    __host__ __device__ bool next(int i, Unit& u) const {
        const long L = (long)i * G + c; if (L >= nwg) return false;
        int wgid = (int)L; { const int q = nwg / NXCD, r = nwg % NXCD, xcd = wgid % NXCD, off = wgid / NXCD; wgid = (xcd < r ? xcd * (q + 1) : r * (q + 1) + (xcd - r) * q) + off; }
        const int nig = WGM * nN, gid = wgid / nig, fm = gid * WGM, gsz = (nM - fm) < WGM ? (nM - fm) : WGM;
        u.pm = fm + ((wgid % nig) % gsz); u.pn = (wgid % nig) / gsz; return true;
    }
    __device__ __forceinline__ void a_ready(const Unit&) const {}
    __device__ __forceinline__ void done(const Unit&) const {}
};
typedef __bf16 bf16v2_t __attribute__((ext_vector_type(2)));
typedef float f32v2_t __attribute__((ext_vector_type(2)));
__device__ __forceinline__ unsigned cvt_pk_bf16(float lo, float hi) { const f32v2_t f = {lo, hi}; const bf16v2_t v = __builtin_convertvector(f, bf16v2_t); return __builtin_bit_cast(unsigned, v); }
template <class Epi, class Sched, bool ALIGN_EPI = false, bool SP2 = false>
__device__ __forceinline__ void gemm_phase(PG8_LAS unsigned char* lds, const Gemm g, const Sched& S, const Epi& E) {
    const int tid = threadIdx.x, wid = __builtin_amdgcn_readfirstlane(tid >> 6), lane = tid & 63, wr = wid >> 2, wc = wid & 3, fr = lane & 15, fq = lane >> 4;
    const int K = g.K, nt = K / BK;
    unsigned voffA[2], voffB[2];
#pragma unroll
    for (int i = 0; i < 2; ++i) { int R, C; stage_rc(tid * 16 + i * 8192, R, C); const int Rb = Epi::PERM ? ((R & ~31) + perm32(R & 31)) : R;
        voffA[i] = (unsigned)(R * K + C) * 2u; voffB[i] = (unsigned)(Rb * K + C) * 2u; }
    const size_t kstep = (size_t)(BK * 2);
    const size_t hstep = (size_t)HALF * K * 2;
    const size_t tstep = 2 * hstep;
    const unsigned ldsw = (unsigned)wid * 1024u;
    const int aoff = lds_byte(wr * 64 + fr, fq * 8), boff = lds_byte(wc * 32 + fr, fq * 8);
#define PG8_SA(b, h) (((b) * 2 + (h)) * HTB)
#define PG8_SB(b, h) ((4 + (b) * 2 + (h)) * HTB)
#define PG8_STAGE(bufoff, gbase, voff) do { _Pragma("unroll") for (int _i = 0; _i < 2; ++_i) \
        __builtin_amdgcn_global_load_lds((const unsigned*)((const char*)(gbase) + (voff)[_i]), (PG8_LAS unsigned*)(lds + (bufoff) + ldsw + _i * 8192), 16, 0, 0); } while (0)
#define PG8_LDA(dst, b, h) do { _Pragma("unroll") for (int m = 0; m < 4; ++m) _Pragma("unroll") for (int k = 0; k < 2; ++k) dst[m][k] = *(const PG8_LAS bf16x8*)(lds + PG8_SA(b, h) + aoff + m * 2048 + k * 1024); } while (0)
#define PG8_LDB(dst, b, h) do { _Pragma("unroll") for (int n = 0; n < 2; ++n) _Pragma("unroll") for (int k = 0; k < 2; ++k) dst[n][k] = *(const PG8_LAS bf16x8*)(lds + PG8_SB(b, h) + boff + n * 2048 + k * 1024); } while (0)
#define PG8_MMA(ai, bj, At, Bt) do { __builtin_amdgcn_s_setprio(1); _Pragma("unroll") for (int m = 0; m < 4; ++m) _Pragma("unroll") for (int n = 0; n < 2; ++n) _Pragma("unroll") for (int k = 0; k < 2; ++k) \
        acc[ai][bj][m][n] = __builtin_amdgcn_mfma_f32_16x16x32_bf16(Bt[n][k], At[m][k], acc[ai][bj][m][n], 0, 0, 0); __builtin_amdgcn_s_setprio(0); } while (0)
#define PG8_WAIT_V(n) asm volatile("s_waitcnt vmcnt(" #n ")" ::: "memory")
#define PG8_WAIT_L(n) asm volatile("s_waitcnt lgkmcnt(" #n ")" ::: "memory")
#define PG8_BAR __builtin_amdgcn_s_barrier()
#define PG8_SCHED __builtin_amdgcn_sched_barrier(0)
    Unit cur, nxt; int ui = 0;
    if (!S.next(0, cur)) return;
    f32x4 acc[2][2][4][2];
#pragma unroll
    for (int a = 0; a < 2; ++a)
#pragma unroll
        for (int b = 0; b < 2; ++b)
#pragma unroll
            for (int m = 0; m < 4; ++m)
#pragma unroll
                for (int n = 0; n < 2; ++n) acc[a][b][m][n] = (f32x4){0.f, 0.f, 0.f, 0.f};
    bf16x8 At[4][2], B0[2][2], B1[2][2];
    const char* cA = (const char*)g.A + (size_t)cur.pm * tstep; const char* cB = (const char*)g.Bt + (size_t)cur.pn * tstep;
    S.a_ready(cur);
    if constexpr (SP2) {
        PG8_STAGE(PG8_SB(0, 0), cB, voffB); PG8_STAGE(PG8_SB(0, 1), cB + hstep, voffB); PG8_STAGE(PG8_SA(0, 0), cA, voffA); PG8_STAGE(PG8_SA(0, 1), cA + hstep, voffA);
        if (wr == 1) PG8_BAR;
        PG8_WAIT_V(2); PG8_BAR;
        PG8_STAGE(PG8_SB(1, 0), cB + kstep, voffB); PG8_STAGE(PG8_SA(1, 0), cA + kstep, voffA); PG8_STAGE(PG8_SB(1, 1), cB + hstep + kstep, voffB);
        PG8_WAIT_V(6); PG8_BAR;
    } else {
        PG8_STAGE(PG8_SB(0, 0), cB, voffB); PG8_STAGE(PG8_SA(0, 0), cA, voffA); PG8_STAGE(PG8_SB(0, 1), cB + hstep, voffB); PG8_STAGE(PG8_SA(0, 1), cA + hstep, voffA);
        if (wr == 1) PG8_BAR;
        PG8_WAIT_V(4); PG8_BAR;
        PG8_STAGE(PG8_SB(1, 0), cB + kstep, voffB); PG8_STAGE(PG8_SA(1, 0), cA + kstep, voffA); PG8_STAGE(PG8_SB(1, 1), cB + hstep + kstep, voffB);
        PG8_WAIT_V(6); PG8_BAR;
    }
    for (;;) {
        const bool has_next = S.next(ui + 1, nxt);
        const char* nA = has_next ? (const char*)g.A + (size_t)nxt.pm * tstep : cA; const char* nB = has_next ? (const char*)g.Bt + (size_t)nxt.pn * tstep : cB;
        for (int t = 0; t < nt; t += 2) {
            const bool last = (t == nt - 2);
            const char* a1 = cA + (size_t)(t + 1) * kstep;
            const char* a2 = last ? nA : cA + (size_t)(t + 2) * kstep; const char* b2 = last ? nB : cB + (size_t)(t + 2) * kstep;
            const char* a3 = a2 + kstep; const char* b3 = b2 + kstep;
            if (last && has_next) S.a_ready(nxt);
            if constexpr (SP2) {
            PG8_LDB(B0, 0, 0); PG8_LDB(B1, 0, 1); PG8_SCHED; PG8_LDA(At, 0, 0); PG8_STAGE(PG8_SA(1, 1), a1 + hstep, voffA);
            PG8_WAIT_V(8); PG8_WAIT_L(0); PG8_BAR; PG8_MMA(0, 0, At, B0); PG8_MMA(0, 1, At, B1); PG8_BAR; PG8_SCHED;
            PG8_LDA(At, 0, 1); PG8_STAGE(PG8_SB(0, 0), b2, voffB); PG8_STAGE(PG8_SB(0, 1), b2 + hstep, voffB); PG8_STAGE(PG8_SA(0, 0), a2, voffA);
            PG8_WAIT_V(8); PG8_WAIT_L(0); PG8_BAR; PG8_MMA(1, 0, At, B0); PG8_MMA(1, 1, At, B1); PG8_BAR; PG8_SCHED;
            PG8_LDB(B0, 1, 0); PG8_LDB(B1, 1, 1); PG8_SCHED; PG8_LDA(At, 1, 0); PG8_STAGE(PG8_SA(0, 1), a2 + hstep, voffA);
            PG8_WAIT_V(8); PG8_WAIT_L(0); PG8_BAR; PG8_MMA(0, 0, At, B0); PG8_MMA(0, 1, At, B1); PG8_BAR; PG8_SCHED;
            PG8_LDA(At, 1, 1); PG8_STAGE(PG8_SB(1, 0), b3, voffB); PG8_STAGE(PG8_SB(1, 1), b3 + hstep, voffB); PG8_STAGE(PG8_SA(1, 0), a3, voffA);
            PG8_WAIT_V(8); PG8_WAIT_L(0); PG8_BAR; PG8_MMA(1, 0, At, B0); PG8_MMA(1, 1, At, B1); PG8_BAR; PG8_SCHED;
            } else {
            PG8_LDB(B0, 0, 0); PG8_SCHED; PG8_LDA(At, 0, 0); PG8_STAGE(PG8_SA(1, 1), a1 + hstep, voffA);
            PG8_WAIT_L(8); PG8_BAR; PG8_WAIT_L(0); PG8_MMA(0, 0, At, B0); PG8_BAR; PG8_SCHED;
            PG8_LDB(B1, 0, 1); PG8_STAGE(PG8_SB(0, 0), b2, voffB);
            PG8_BAR; PG8_WAIT_L(0); PG8_MMA(0, 1, At, B1); PG8_BAR;
            PG8_LDA(At, 0, 1); PG8_STAGE(PG8_SA(0, 0), a2, voffA);
            PG8_BAR; PG8_WAIT_L(0); PG8_MMA(1, 0, At, B0); PG8_BAR; PG8_SCHED;
            PG8_STAGE(PG8_SB(0, 1), b2 + hstep, voffB);
            PG8_WAIT_V(6); PG8_BAR; PG8_MMA(1, 1, At, B1); PG8_BAR;
            PG8_LDB(B0, 1, 0); PG8_SCHED; PG8_LDA(At, 1, 0); PG8_STAGE(PG8_SA(0, 1), a2 + hstep, voffA);
            PG8_WAIT_L(8); PG8_BAR; PG8_WAIT_L(0); PG8_MMA(0, 0, At, B0); PG8_BAR; PG8_SCHED;
            PG8_LDB(B1, 1, 1); PG8_STAGE(PG8_SB(1, 0), b3, voffB);
            PG8_BAR; PG8_WAIT_L(0); PG8_MMA(0, 1, At, B1); PG8_BAR;
            PG8_LDA(At, 1, 1); PG8_STAGE(PG8_SA(1, 0), a3, voffA);
            PG8_BAR; PG8_WAIT_L(0); PG8_MMA(1, 0, At, B0); PG8_BAR; PG8_SCHED;
            PG8_STAGE(PG8_SB(1, 1), b3 + hstep, voffB);
            PG8_WAIT_V(6); PG8_BAR; PG8_MMA(1, 1, At, B1); PG8_BAR;
            }
        }
        if constexpr (ALIGN_EPI) { if (wr == 0) PG8_BAR; }
        if constexpr (!Epi::AFTER_DRAIN) { E(acc, cur, wr, wc, fr, fq); S.done(cur); }
        if (!has_next) break;
#pragma unroll
        for (int a = 0; a < 2; ++a)
#pragma unroll
            for (int b = 0; b < 2; ++b)
#pragma unroll
                for (int m = 0; m < 4; ++m)
#pragma unroll
                    for (int n = 0; n < 2; ++n) acc[a][b][m][n] = (f32x4){0.f, 0.f, 0.f, 0.f};
        cur = nxt; cA = nA; cB = nB; ++ui;
        if constexpr (ALIGN_EPI) { if (wr == 1) PG8_BAR; }
    }
    PG8_WAIT_V(0);
    if constexpr (!ALIGN_EPI) { if (wr == 0) PG8_BAR; }
    PG8_BAR;
    if constexpr (Epi::AFTER_DRAIN) { E.fused(acc, cur, wr, wc, fr, fq, lds, wid, lane); S.done(cur); }
#undef PG8_SA
#undef PG8_SB
#undef PG8_STAGE
#undef PG8_LDA
#undef PG8_LDB
#undef PG8_MMA
#undef PG8_WAIT_V
#undef PG8_WAIT_L
#undef PG8_BAR
#undef PG8_SCHED
}
}

namespace cg = cooperative_groups;
using pg8::bf16_t; using pg8::bf16x8; using pg8::f32x4; using pg8::u32x4;
typedef short s16x4 __attribute__((ext_vector_type(4)));
typedef unsigned u32x2 __attribute__((ext_vector_type(2)));
typedef float f32x2 __attribute__((ext_vector_type(2)));
#define LAS __attribute__((address_space(3)))
#define DI __device__ __forceinline__

#ifndef GEMM_ALIGN
#define GEMM_ALIGN true
#endif
#ifndef GEMM_SP2
#define GEMM_SP2 true
#endif
#ifndef N_LAUNCHES
#define N_LAUNCHES 1
#endif

constexpr int DM = 1024, NB = 8, SEQ = 8192, CTXL = 256;
constexpr int ML = NB * SEQ, MC = NB * CTXL, MALL = ML + MC;
constexpr int NSCAN = 5184, NSCAN_PAD = 5376, NMERGE = 4096, FFN = 2816, NGU = 5632;
constexpr int NCHUNK = 132, NPHASE = 12;
constexpr float EPSF = 1e-6f, LOG2E = 1.4426950408889634f, LN2 = 0.6931471805599453f;

constexpr size_t OFF_WSCAN = 0;
constexpr size_t OFF_WMERGE = OFF_WSCAN + (size_t)NSCAN_PAD * DM * 2;
constexpr size_t OFF_WOUT = OFF_WMERGE + (size_t)NMERGE * DM * 2;
constexpr size_t OFF_WGU = OFF_WOUT + (size_t)DM * DM * 2;
constexpr size_t OFF_WD = OFF_WGU + (size_t)NGU * DM * 2;
constexpr size_t OFF_MOD = OFF_WD + (size_t)DM * FFN * 2;
constexpr size_t OFF_SS = OFF_MOD + 221184;
constexpr size_t OFF_HN = OFF_SS + (size_t)ML * 32 * 4;
constexpr size_t OFF_TINV = OFF_HN + (size_t)MALL * DM * 2;
constexpr size_t OFF_PSCAN = OFF_TINV + (size_t)NCHUNK * NB * 8 * 2 * 4096 * 2;
constexpr size_t WS_END = OFF_PSCAN + (size_t)MALL * NSCAN * 2;
constexpr size_t OFF_M = OFF_PSCAN;
constexpr size_t OFF_H = OFF_PSCAN;
constexpr size_t OFF_X1 = OFF_PSCAN + (size_t)ML * FFN * 2;
static_assert(OFF_X1 + (size_t)ML * DM * 4 <= WS_END, "overlay");
static_assert(WS_END + 4096 + 16384 <= (size_t)1073741824, "workspace");
constexpr size_t OFF_Y1 = OFF_X1;
constexpr size_t OFF_Y2 = OFF_TINV;
constexpr size_t OFF_CTR = WS_END;
constexpr size_t OFF_XBAR = WS_END + 4096;
constexpr int LDS_XB = 147456, LDS_BYTES = 147456 + 16;

struct Params {
    const float *x, *c, *ctx, *c_ctx, *w_mod, *b_mod, *norm1_w, *norm2_w, *w_in, *gla_lr_w, *gla_lr_b, *gla_norm_w, *gdn_conv_w, *gdn_a_log,
        *gdn_dt_bias, *gdn_norm_w, *w_out, *ffn_w_gate, *ffn_w_up, *ffn_w_down, *final_norm_w;
    float* out; unsigned char* ws; int ph_lo, ph_hi;
};

DI float wave_sum(float v) {
#pragma unroll
    for (int o = 1; o < 64; o <<= 1) v += __shfl_xor(v, o);
    return v;
}
DI unsigned pk2(float lo, float hi) { return pg8::cvt_pk_bf16(lo, hi); }
DI float bflo(unsigned w) { return __uint_as_float(w << 16); }
DI float bfhi(unsigned w) { return __uint_as_float(w & 0xffff0000u); }
DI float bf2f(bf16_t v) { return __uint_as_float(((unsigned)v) << 16); }
DI bf16_t f2bf(float f) { return (bf16_t)(pk2(f, 0.f) & 0xffffu); }
DI float ex2(float x) { return __builtin_amdgcn_exp2f(x); }
DI float lg2(float x) { return __builtin_amdgcn_logf(x); }
DI float rcpf_(float x) { return __builtin_amdgcn_rcpf(x); }
DI float sigm(float x) { return rcpf_(1.f + ex2(-LOG2E * x)); }
DI float silu_(float x) { return x * sigm(x); }
DI float softplus_(float x) {
    const float t = ex2(-LOG2E * fabsf(x));
    const float l = t < 0.01f ? t * (1.f - t * (0.5f - t * 0.33333333f)) : LN2 * lg2(1.f + t);
    return fmaxf(x, 0.f) + l;
}
DI f32x4 mfma16(bf16x8 a, bf16x8 b, f32x4 c) { return __builtin_amdgcn_mfma_f32_16x16x32_bf16(a, b, c, 0, 0, 0); }
DI bf16x8 ldsRow(LAS const unsigned char* p) { return *(LAS const bf16x8*)p; }
DI bf16x8 ldsT(LAS const unsigned char* img, int pitch, int k0, int m0, int lane) {
    const int g = lane >> 4, i16 = lane & 15;
    LAS const unsigned char* a = img + (k0 + 8 * g + (i16 >> 2)) * pitch + 2 * m0 + 8 * (i16 & 3);
    const s16x4 lo = __builtin_amdgcn_ds_read_tr16_b64_v4i16((LAS s16x4*)a);
    const s16x4 hi = __builtin_amdgcn_ds_read_tr16_b64_v4i16((LAS s16x4*)(a + 4 * pitch));
    return __builtin_shufflevector(lo, hi, 0, 1, 2, 3, 4, 5, 6, 7);
}
DI u32x2 pack4(f32x4 v) { u32x2 o; o.x = pk2(v[0], v[1]); o.y = pk2(v[2], v[3]); return o; }
DI void lds_wait() { asm volatile("s_waitcnt lgkmcnt(0)" ::: "memory"); }
DI void lds_barrier() { asm volatile("s_waitcnt lgkmcnt(0)" ::: "memory"); __builtin_amdgcn_s_barrier(); asm volatile("" ::: "memory"); }

DI void tr_item(const float* W, int ldw, int srccol, int k0, bf16_t* dst, int K, LAS float* scr, int lane) {
#pragma unroll 8
    for (int i = 0; i < 32; ++i) { const int kk = 2 * i + (lane >> 5); scr[kk * 33 + (lane & 31)] = srccol >= 0 ? W[(size_t)(k0 + kk) * ldw + srccol] : 0.f; }
    lds_wait();
    const int c = lane & 7;
#pragma unroll
    for (int j = 0; j < 4; ++j) { const int n = (lane >> 3) + 8 * j; LAS const float* s = scr + (8 * c) * 33 + n;
        u32x4 o; o.x = pk2(s[0], s[33]); o.y = pk2(s[66], s[99]); o.z = pk2(s[132], s[165]); o.w = pk2(s[198], s[231]);
        *(u32x4*)(dst + (size_t)n * K + 8 * c) = o; }
    lds_wait();
}
DI int src_scan(int n) { return n < 2048 ? n : (n < 5120 ? 3104 + (n - 2048) : (n < 5152 ? 3072 + (n - 5120) : (n < 5184 ? 7200 + (n - 5152) : -1))); }
DI int src_merge(int n) {
    const int pn = n >> 8, ct = n & 255, bj = ct >> 7, wc = (ct >> 5) & 3, nn = (ct >> 4) & 1, r = ct & 15, ch = 64 * pn + 16 * wc + r;
    const int base = bj == 0 ? (nn == 0 ? 2048 : 7232) : (nn == 0 ? 6176 : 8256);
    return base + ch;
}
DI void phase0(const Params& p, LAS unsigned char* lds) {
    const int tid = threadIdx.x, wave = tid >> 6, lane = tid & 63;
    const int gw = blockIdx.x * 8 + wave, NGW = gridDim.x * 8;
    LAS float* scr = (LAS float*)(lds + wave * 8448);
    bf16_t* Wscan = (bf16_t*)(p.ws + OFF_WSCAN); bf16_t* Wmerge = (bf16_t*)(p.ws + OFF_WMERGE); bf16_t* Wout = (bf16_t*)(p.ws + OFF_WOUT);
    bf16_t* Wgu = (bf16_t*)(p.ws + OFF_WGU); bf16_t* Wd = (bf16_t*)(p.ws + OFF_WD);
    constexpr int I_SCAN = 16 * (NSCAN_PAD / 32), I_MERGE = 16 * (NMERGE / 32), I_OUT = 16 * 32, I_GU = 16 * (NGU / 32), I_D = (FFN / 64) * 32;
    constexpr int NITEMS = I_SCAN + I_MERGE + I_OUT + I_GU + I_D;
    if (blockIdx.x == 0 && tid == 0) *(unsigned*)(p.ws + OFF_CTR) = 0u;
    {
        LAS float* st = (LAS float*)(lds + 8 * 8448);
        for (int idx = tid; idx < 9 * 1024; idx += 512) { const int b = idx >> 10, k = idx & 1023; st[idx] = silu_(b < 8 ? p.c[b * DM + k] : p.c_ctx[k]); }
        __syncthreads();
    }
    for (int it = gw; it < NITEMS; it += NGW) {
        int r = it;
        if (r < I_SCAN) { const int nblk = NSCAN_PAD / 32, kb = r / nblk, nb = r % nblk, n0 = 32 * nb;
            tr_item(p.w_in, 9280, src_scan(n0 + (lane & 31)), 64 * kb, Wscan + (size_t)n0 * DM + 64 * kb, DM, scr, lane); continue; }
        r -= I_SCAN;
        if (r < I_MERGE) { const int nblk = NMERGE / 32, kb = r / nblk, nb = r % nblk, n0 = 32 * nb;
            tr_item(p.w_in, 9280, src_merge(n0 + (lane & 31)), 64 * kb, Wmerge + (size_t)n0 * DM + 64 * kb, DM, scr, lane); continue; }
        r -= I_MERGE;
        if (r < I_OUT) { const int nblk = 32, kb = r / nblk, nb = r % nblk, n0 = 32 * nb;
            tr_item(p.w_out, DM, n0 + (lane & 31), 64 * kb, Wout + (size_t)n0 * DM + 64 * kb, DM, scr, lane); continue; }
        r -= I_OUT;
        if (r < I_GU) { const int nblk = NGU / 32, kb = r / nblk, nb = r % nblk, n0 = 32 * nb;
            const int pn = n0 >> 8, ct = n0 & 255; const float* W = ct < 128 ? p.ffn_w_gate : p.ffn_w_up; const int c0 = 128 * pn + (ct & 127);
            tr_item(W, FFN, c0 + (lane & 31), 64 * kb, Wgu + (size_t)n0 * DM + 64 * kb, DM, scr, lane); continue; }
        r -= I_GU;
        { const int nblk = 32, kb = r / nblk, nb = r % nblk, n0 = 32 * nb;
            tr_item(p.ffn_w_down, DM, n0 + (lane & 31), 64 * kb, Wd + (size_t)n0 * FFN + 64 * kb, FFN, scr, lane); }
    }
    float* mod = (float*)(p.ws + OFF_MOD);
    LAS const float* stab = (LAS const float*)(lds + 8 * 8448);
    for (int it = gw; it < 384; it += NGW) {
        const int col = it * 16 + (lane & 15), kq = lane >> 4;
        float acc[9];
#pragma unroll
        for (int b = 0; b < 9; ++b) acc[b] = 0.f;
#pragma unroll 8
        for (int kk = 0; kk < 256; ++kk) {
            const int k = 256 * kq + kk;
            const float w = p.w_mod[(size_t)k * 6144 + col];
#pragma unroll
            for (int b = 0; b < 9; ++b) acc[b] += stab[b * 1024 + k] * w;
        }
#pragma unroll
        for (int b = 0; b < 9; ++b) { acc[b] += __shfl_xor(acc[b], 16); acc[b] += __shfl_xor(acc[b], 32); }
        if (kq == 0) { const float bias = p.b_mod[col];
#pragma unroll
            for (int b = 0; b < 9; ++b) mod[b * 6144 + col] = acc[b] + bias; }
    }
}

DI void norm_mod_row(const float* xr, bf16_t* orow, const float* nw, const float* shift, const float* scale, int lane) {
    f32x4 v[4]; float s = 0.f;
#pragma unroll
    for (int j = 0; j < 4; ++j) { v[j] = *(const f32x4*)(xr + 4 * lane + 256 * j); s += (v[j][0] * v[j][0] + v[j][1] * v[j][1]) + (v[j][2] * v[j][2] + v[j][3] * v[j][3]); }
    const float rstd = rsqrtf(wave_sum(s) * (1.f / DM) + EPSF);
#pragma unroll
    for (int j = 0; j < 4; ++j) {
        const int cidx = 4 * lane + 256 * j;
        const f32x4 w = *(const f32x4*)(nw + cidx), sh = *(const f32x4*)(shift + cidx), sc = *(const f32x4*)(scale + cidx);
        f32x4 y;
#pragma unroll
        for (int e = 0; e < 4; ++e) y[e] = (v[j][e] * rstd * w[e]) * (1.f + sc[e]) + sh[e];
        *(u32x2*)(orow + cidx) = pack4(y);
    }
}
DI void phase_hn(const Params& p) {
    const int wave = threadIdx.x >> 6, lane = threadIdx.x & 63, gw = blockIdx.x * 8 + wave, NGW = gridDim.x * 8;
    const float* mod = (const float*)(p.ws + OFF_MOD); bf16_t* hn = (bf16_t*)(p.ws + OFF_HN);
    for (int r = gw; r < MALL; r += NGW) {
        const float* xr = r < ML ? p.x + (size_t)r * DM : p.ctx + (size_t)(r - ML) * DM;
        const int mb = r < ML ? r / SEQ : 8;
        norm_mod_row(xr, hn + (size_t)r * DM, p.norm1_w, mod + mb * 6144, mod + mb * 6144 + 1024, lane);
    }
}
DI void phase_hn2(const Params& p) {
    const int wave = threadIdx.x >> 6, lane = threadIdx.x & 63, gw = blockIdx.x * 8 + wave, NGW = gridDim.x * 8;
    const float* mod = (const float*)(p.ws + OFF_MOD); bf16_t* hn = (bf16_t*)(p.ws + OFF_HN); const bf16_t* y1 = (const bf16_t*)(p.ws + OFF_Y1);
    for (int r = gw; r < ML; r += NGW) {
        const int mb = r / SEQ; const float* xr = p.x + (size_t)r * DM; const bf16_t* yr = y1 + (size_t)r * DM; bf16_t* orow = hn + (size_t)r * DM;
        f32x4 v[4]; float s = 0.f;
#pragma unroll
        for (int j = 0; j < 4; ++j) { const int cidx = 4 * lane + 256 * j; const u32x2 yy = *(const u32x2*)(yr + cidx); v[j] = *(const f32x4*)(xr + cidx);
            v[j][0] += bflo(yy.x); v[j][1] += bfhi(yy.x); v[j][2] += bflo(yy.y); v[j][3] += bfhi(yy.y);
            s += (v[j][0] * v[j][0] + v[j][1] * v[j][1]) + (v[j][2] * v[j][2] + v[j][3] * v[j][3]); }
        const float rstd = rsqrtf(wave_sum(s) * (1.f / DM) + EPSF);
        const float* shift = mod + mb * 6144 + 3072; const float* scale = mod + mb * 6144 + 4096;
#pragma unroll
        for (int j = 0; j < 4; ++j) {
            const int cidx = 4 * lane + 256 * j;
            const f32x4 w = *(const f32x4*)(p.norm2_w + cidx), sh = *(const f32x4*)(shift + cidx), sc = *(const f32x4*)(scale + cidx);
            f32x4 y;
#pragma unroll
            for (int e = 0; e < 4; ++e) y[e] = (v[j][e] * rstd * w[e]) * (1.f + sc[e]) + sh[e];
            *(u32x2*)(orow + cidx) = pack4(y);
        }
    }
}
DI void phase_final(const Params& p) {
    const int wave = threadIdx.x >> 6, lane = threadIdx.x & 63, gw = blockIdx.x * 8 + wave, NGW = gridDim.x * 8;
    const bf16_t* y1 = (const bf16_t*)(p.ws + OFF_Y1); const bf16_t* y2 = (const bf16_t*)(p.ws + OFF_Y2);
    for (int r = gw; r < ML; r += NGW) {
        const float* xr = p.x + (size_t)r * DM; const bf16_t* yr = y2 + (size_t)r * DM; const bf16_t* y1r = y1 + (size_t)r * DM; float* orow = p.out + (size_t)r * DM;
        f32x4 v[4]; float s = 0.f;
#pragma unroll
        for (int j = 0; j < 4; ++j) { const int cidx = 4 * lane + 256 * j; const u32x2 yy = *(const u32x2*)(yr + cidx), y1v = *(const u32x2*)(y1r + cidx); v[j] = *(const f32x4*)(xr + cidx);
            v[j][0] += bflo(y1v.x); v[j][1] += bfhi(y1v.x); v[j][2] += bflo(y1v.y); v[j][3] += bfhi(y1v.y);
            v[j][0] += bflo(yy.x); v[j][1] += bfhi(yy.x); v[j][2] += bflo(yy.y); v[j][3] += bfhi(yy.y);
            s += (v[j][0] * v[j][0] + v[j][1] * v[j][1]) + (v[j][2] * v[j][2] + v[j][3] * v[j][3]); }
        const float rstd = rsqrtf(wave_sum(s) * (1.f / DM) + EPSF);
#pragma unroll
        for (int j = 0; j < 4; ++j) { const f32x4 w = *(const f32x4*)(p.final_norm_w + 4 * lane + 256 * j); f32x4 y;
#pragma unroll
            for (int e = 0; e < 4; ++e) y[e] = v[j][e] * rstd * w[e];
            *(f32x4*)(orow + 4 * lane + 256 * j) = y; }
    }
}

struct EpiScan {
    static constexpr bool PERM = true, AFTER_DRAIN = false;
    bf16_t* O;
    __device__ __forceinline__ void operator()(const f32x4 (&acc)[2][2][4][2], const pg8::Unit& u, int wr, int wc, int fr, int fq) const {
        const int row0 = u.pm * 256 + wr * 64 + fr, colt = u.pn * 256 + wc * 32 + 8 * fq;
#pragma unroll
        for (int ai = 0; ai < 2; ++ai)
#pragma unroll
            for (int m = 0; m < 4; ++m) { bf16_t* rowp = O + (size_t)(row0 + ai * 128 + m * 16) * NSCAN + colt;
#pragma unroll
                for (int bj = 0; bj < 2; ++bj) if (colt + bj * 128 < NSCAN) {
                    const f32x4 v0 = acc[ai][bj][m][0], v1 = acc[ai][bj][m][1];
                    u32x4 w; w.x = pk2(v0[0], v0[1]); w.y = pk2(v0[2], v0[3]); w.z = pk2(v1[0], v1[1]); w.w = pk2(v1[2], v1[3]);
                    *(u32x4*)(rowp + bj * 128) = w; } }
    }
};
struct EpiMerge {
    static constexpr bool PERM = false, AFTER_DRAIN = false;
    const bf16_t* O; const float* ss; const float* gw_gla; const float* gw_gdn; bf16_t* Mo;
    __device__ __forceinline__ void operator()(const f32x4 (&acc)[2][2][4][2], const pg8::Unit& u, int wr, int wc, int fr, int fq) const {
        const int ch = u.pn * 64 + wc * 16 + 4 * fq, hg = ch >> 8, hd = ch >> 7;
        const f32x4 gg = *(const f32x4*)(gw_gla + ch), gd = *(const f32x4*)(gw_gdn + ch);
        const int rowb = u.pm * 256 + wr * 64 + fr;
#pragma unroll
        for (int ai = 0; ai < 2; ++ai) {
            u32x2 og[4], od[4]; f32x4 s4[4]; f32x2 s2[4];
#pragma unroll
            for (int m = 0; m < 4; ++m) { const size_t row = (size_t)(rowb + ai * 128 + m * 16);
                og[m] = *(const u32x2*)(O + row * 2048 + ch); od[m] = *(const u32x2*)(O + row * 2048 + 1024 + ch);
                s4[m] = *(const f32x4*)(ss + row * 32 + 4 * hg); s2[m] = *(const f32x2*)(ss + row * 32 + 16 + 2 * hd); }
#pragma unroll
            for (int m = 0; m < 4; ++m) {
                const int row = rowb + ai * 128 + m * 16;
                const float rg = rsqrtf(((s4[m][0] + s4[m][1]) + (s4[m][2] + s4[m][3])) * (1.f / 256.f) + EPSF), rd = rsqrtf((s2[m][0] + s2[m][1]) * (1.f / 128.f) + EPSF);
                const float ogf[4] = {bflo(og[m].x), bfhi(og[m].x), bflo(og[m].y), bfhi(og[m].y)}, odf[4] = {bflo(od[m].x), bfhi(od[m].x), bflo(od[m].y), bfhi(od[m].y)};
                f32x4 mv;
#pragma unroll
                for (int j = 0; j < 4; ++j) {
                    const float zg = acc[ai][0][m][0][j], ggv = acc[ai][0][m][1][j], zd = acc[ai][1][m][0][j], gdv = acc[ai][1][m][1][j];
                    const float dg = (1.f + ex2(-LOG2E * zg)) * (1.f + ex2(-LOG2E * ggv)), dd = (1.f + ex2(-LOG2E * zd)) * (1.f + ex2(-LOG2E * gdv));
                    mv[j] = ogf[j] * rg * gg[j] * zg * rcpf_(dg) + odf[j] * rd * gd[j] * zd * rcpf_(dd);
                }
                *(u32x2*)(Mo + (size_t)row * DM + ch) = pack4(mv);
            }
        }
    }
};
struct EpiRes {
    static constexpr bool PERM = false, AFTER_DRAIN = false;
    const float* base; const float* gate; float* Out;
    __device__ __forceinline__ void operator()(const f32x4 (&acc)[2][2][4][2], const pg8::Unit& u, int wr, int wc, int fr, int fq) const {
        const int row0 = u.pm * 256 + wr * 64 + fr, col0 = u.pn * 256 + wc * 32 + 4 * fq, b = u.pm >> 5;
        f32x4 gv[2][2];
#pragma unroll
        for (int bj = 0; bj < 2; ++bj)
#pragma unroll
            for (int n = 0; n < 2; ++n) gv[bj][n] = *(const f32x4*)(gate + b * 6144 + col0 + bj * 128 + n * 16);
#pragma unroll
        for (int ai = 0; ai < 2; ++ai)
#pragma unroll
            for (int m = 0; m < 4; ++m) { const size_t ro = (size_t)(row0 + ai * 128 + m * 16) * DM + col0;
#pragma unroll
                for (int bj = 0; bj < 2; ++bj)
#pragma unroll
                    for (int n = 0; n < 2; ++n) { const f32x4 bv = *(const f32x4*)(base + ro + bj * 128 + n * 16);
                        *(f32x4*)(Out + ro + bj * 128 + n * 16) = bv + gv[bj][n] * acc[ai][bj][m][n]; } }
    }
};
struct EpiY {
    static constexpr bool PERM = true, AFTER_DRAIN = false;
    const float* gate; bf16_t* Y;
    __device__ __forceinline__ void operator()(const f32x4 (&acc)[2][2][4][2], const pg8::Unit& u, int wr, int wc, int fr, int fq) const {
        const int row0 = u.pm * 256 + wr * 64 + fr, col0 = u.pn * 256 + wc * 32 + 8 * fq, b = u.pm >> 5;
        f32x4 gv[2][2];
#pragma unroll
        for (int bj = 0; bj < 2; ++bj)
#pragma unroll
            for (int n = 0; n < 2; ++n) gv[bj][n] = *(const f32x4*)(gate + b * 6144 + col0 + bj * 128 + 4 * n);
#pragma unroll
        for (int ai = 0; ai < 2; ++ai)
#pragma unroll
            for (int m = 0; m < 4; ++m) { bf16_t* rowp = Y + (size_t)(row0 + ai * 128 + m * 16) * DM + col0;
#pragma unroll
                for (int bj = 0; bj < 2; ++bj) { const f32x4 v0 = acc[ai][bj][m][0] * gv[bj][0], v1 = acc[ai][bj][m][1] * gv[bj][1];
                    u32x4 w; w.x = pk2(v0[0], v0[1]); w.y = pk2(v0[2], v0[3]); w.z = pk2(v1[0], v1[1]); w.w = pk2(v1[2], v1[3]);
                    *(u32x4*)(rowp + bj * 128) = w; } }
    }
};
struct EpiGU {
    static constexpr bool PERM = true, AFTER_DRAIN = false;
    bf16_t* H;
    __device__ __forceinline__ void operator()(const f32x4 (&acc)[2][2][4][2], const pg8::Unit& u, int wr, int wc, int fr, int fq) const {
        const int row0 = u.pm * 256 + wr * 64 + fr, col0 = u.pn * 128 + wc * 32 + 8 * fq;
#pragma unroll
        for (int ai = 0; ai < 2; ++ai)
#pragma unroll
            for (int m = 0; m < 4; ++m) {
                f32x4 h0, h1;
#pragma unroll
                for (int j = 0; j < 4; ++j) { h0[j] = silu_(acc[ai][0][m][0][j]) * acc[ai][1][m][0][j]; h1[j] = silu_(acc[ai][0][m][1][j]) * acc[ai][1][m][1][j]; }
                u32x4 w; w.x = pk2(h0[0], h0[1]); w.y = pk2(h0[2], h0[3]); w.z = pk2(h1[0], h1[1]); w.w = pk2(h1[2], h1[3]);
                *(u32x4*)(H + (size_t)(row0 + ai * 128 + m * 16) * FFN + col0) = w; }
    }
};

template <int RPL>
DI void conv_tile(bf16_t* P, size_t row0, size_t rstride, int slice, const float* conv_w, int wave, int lane) {
    constexpr int NR = 32 * RPL;
    const int rq = lane >> 4, cl = lane & 15, rbase = (wave * 4 + rq) * RPL, ch = slice * 128 + cl * 8;
    bf16_t* colp = P + 2048 + ch;
    u32x4 in[RPL + 4];
#pragma unroll
    for (int t = 0; t < RPL + 4; ++t) { const int r = rbase + t - 2;
        in[t] = (r >= 0 && r < NR) ? *(const u32x4*)(colp + (row0 + (size_t)r * rstride) * NSCAN) : (u32x4){0u, 0u, 0u, 0u}; }
    float w[5][8];
#pragma unroll
    for (int i = 0; i < 5; ++i) { const f32x4 a = *(const f32x4*)(conv_w + i * 3072 + ch), b = *(const f32x4*)(conv_w + i * 3072 + ch + 4);
#pragma unroll
        for (int e = 0; e < 4; ++e) { w[i][e] = a[e]; w[i][4 + e] = b[e]; } }
    asm volatile("s_waitcnt vmcnt(0)" ::: "memory");
    __syncthreads();
#pragma unroll
    for (int t = 0; t < RPL; ++t) {
        float acc[8];
#pragma unroll
        for (int e = 0; e < 8; ++e) acc[e] = 0.f;
#pragma unroll
        for (int i = 0; i < 5; ++i) { const u32x4 v = in[t + i];
            acc[0] += w[i][0] * bflo(v.x); acc[1] += w[i][1] * bfhi(v.x); acc[2] += w[i][2] * bflo(v.y); acc[3] += w[i][3] * bfhi(v.y);
            acc[4] += w[i][4] * bflo(v.z); acc[5] += w[i][5] * bfhi(v.z); acc[6] += w[i][6] * bflo(v.w); acc[7] += w[i][7] * bfhi(v.w); }
        float ssq = 0.f;
#pragma unroll
        for (int e = 0; e < 8; ++e) { acc[e] = silu_(acc[e]); ssq += acc[e] * acc[e]; }
        if (slice < 16) {
            ssq += __shfl_xor(ssq, 1); ssq += __shfl_xor(ssq, 2); ssq += __shfl_xor(ssq, 4); ssq += __shfl_xor(ssq, 8);
            const float sc = rsqrtf(ssq + EPSF) * (slice < 8 ? 0.08838834764831845f : 1.f);
#pragma unroll
            for (int e = 0; e < 8; ++e) acc[e] *= sc;
        }
        u32x4 o; o.x = pk2(acc[0], acc[1]); o.y = pk2(acc[2], acc[3]); o.z = pk2(acc[4], acc[5]); o.w = pk2(acc[6], acc[7]);
        *(u32x4*)(colp + (row0 + (size_t)(rbase + t) * rstride) * NSCAN) = o;
    }
}
DI void phase_conv(const Params& p) {
    const int wave = threadIdx.x >> 6, lane = threadIdx.x & 63;
    bf16_t* P = (bf16_t*)(p.ws + OFF_PSCAN);
    constexpr int NLAT = NB * 64 * 24, NCT = NB * 24;
    for (int T = blockIdx.x; T < NLAT + NCT; T += gridDim.x) {
        if (T < NLAT) { const int slice = T % 24, col = (T / 24) % 64, b = T / (24 * 64);
            conv_tile<4>(P, (size_t)b * SEQ + col, 64, slice, p.gdn_conv_w, wave, lane); }
        else { const int T2 = T - NLAT, slice = T2 % 24, b = T2 / 24;
            conv_tile<8>(P, (size_t)ML + (size_t)b * CTXL, 1, slice, p.gdn_conv_w, wave, lane); }
    }
}

template <int DIR> DI int chunk_id(int st) { return DIR == 0 ? st : (st < 4 ? 3 - st : 135 - st); }
DI int gla_base(int b, int cid) { return cid < 4 ? ML + b * CTXL + 64 * cid : b * SEQ + 64 * (cid - 4); }
DI int gdn_row(int b, int cid, int i) {
    if (cid < 4) return ML + b * CTXL + 64 * cid + i;
    const int cl = cid - 4; return b * SEQ + (((cl & 1) * 64 + i) * 64) + (cl >> 1);
}
DI float wave_prefix(float v, int lane) {
    v += __builtin_bit_cast(float, __builtin_amdgcn_update_dpp(0, __builtin_bit_cast(int, v), 0x111, 0xf, 0xf, false));
    v += __builtin_bit_cast(float, __builtin_amdgcn_update_dpp(0, __builtin_bit_cast(int, v), 0x112, 0xf, 0xf, false));
    v += __builtin_bit_cast(float, __builtin_amdgcn_update_dpp(0, __builtin_bit_cast(int, v), 0x114, 0xf, 0xf, false));
    v += __builtin_bit_cast(float, __builtin_amdgcn_update_dpp(0, __builtin_bit_cast(int, v), 0x118, 0xf, 0xf, false));
    const float t0 = __shfl(v, 15), t1 = __shfl(v, 31), t2 = __shfl(v, 47);
    const int row = lane >> 4;
    return v + (row > 0 ? t0 : 0.f) + (row > 1 ? t1 : 0.f) + (row > 2 ? t2 : 0.f);
}
DI void gdn_gates(const Params& p, int dir, int h, float a, float bb, float& g2, float& beta) {
    const float A = __expf(p.gdn_a_log[dir * 8 + h]);
    g2 = -A * softplus_(a + p.gdn_dt_bias[dir * 8 + h]) * LOG2E;
    beta = sigm(bb);
}

template <int I> struct SolveRows {
    static DI void run(f32x2 (&x2)[32], LAS const float* Lm, int lane) {
        f32x2 a2 = {0.f, 0.f};
#pragma unroll
        for (int m4 = 0; m4 < (I + 3) / 4; ++m4) {
            const f32x4 l = *(LAS const f32x4*)(Lm + I * 64 + 4 * m4);
            const f32x2 l01 = {l[0], l[1]}, l23 = {l[2], l[3]};
            if (4 * m4 + 1 < I) a2 = a2 - l01 * x2[2 * m4];
            else if (4 * m4 < I) a2[0] -= l[0] * x2[2 * m4][0];
            if (4 * m4 + 3 < I) a2 = a2 - l23 * x2[2 * m4 + 1];
            else if (4 * m4 + 2 < I) a2[0] -= l[2] * x2[2 * m4 + 1][0];
        }
        const float a = ((lane == I) ? 1.f : 0.f) + (a2[0] + a2[1]);
        if (I & 1) x2[I >> 1][1] = a; else x2[I >> 1][0] = a;
        asm volatile("" ::: "memory");
        SolveRows<I + 1>::run(x2, Lm, lane);
    }
};
template <> struct SolveRows<64> { static DI void run(f32x2 (&)[32], LAS const float*, int) {} };

DI void phase_tinv(const Params& p, LAS unsigned char* lds, int gw0, int NGW) {
    const int tid = threadIdx.x, wave = tid >> 6, lane = tid & 63, r = lane & 15, q = lane >> 4;
    const int gw = gw0 + wave;
    LAS unsigned char* kt = lds + wave * 18432; LAS float* Lm = (LAS float*)kt; LAS float* sc = (LAS float*)(kt + 17408);
    const bf16_t* P = (const bf16_t*)(p.ws + OFF_PSCAN); bf16_t* TI = (bf16_t*)(p.ws + OFF_TINV);
#pragma unroll 1
    for (int it = gw; it < NB * NCHUNK * 16; it += NGW) {
        const int dir = it & 1, h = (it >> 1) & 7, cid = (it >> 4) % NCHUNK, b = it / (16 * NCHUNK);
#pragma unroll
        for (int t = 0; t < 16; ++t) { const int i = q + 4 * t, c16 = r;
            const u32x4 v = *(const u32x4*)(P + (size_t)gdn_row(b, cid, i) * NSCAN + 3072 + 128 * h + 8 * c16);
            *(LAS u32x4*)(kt + q * 272 + 16 * c16 + t * (4 * 272)) = v; }
        {
            const bf16_t* rp = P + (size_t)gdn_row(b, cid, lane) * NSCAN + 5152 + 8 * dir + h;
            float g2, be;
            gdn_gates(p, dir, h, bf2f(rp[0]), bf2f(rp[16]), g2, be);
            const float Pf = wave_prefix(g2, lane), Tall = __shfl(Pf, 63);
            sc[lane] = dir == 0 ? Pf : Tall - Pf + g2; sc[64 + lane] = be;
        }
        lds_wait();
        f32x4 kk[4][4];
#pragma unroll
        for (int a = 0; a < 4; ++a)
#pragma unroll
            for (int c = 0; c < 4; ++c) kk[a][c] = (f32x4){0.f, 0.f, 0.f, 0.f};
#pragma unroll
        for (int ks = 0; ks < 4; ++ks) { bf16x8 fr[4];
#pragma unroll
            for (int t = 0; t < 4; ++t) fr[t] = ldsRow(kt + (16 * t + r) * 272 + 64 * ks + 16 * q);
#pragma unroll
            for (int a = 0; a < 4; ++a)
#pragma unroll
                for (int c = 0; c < 4; ++c) kk[a][c] = mfma16(fr[a], fr[c], kk[a][c]); }
        {
            float Gj[4], Bj[4];
#pragma unroll
            for (int c = 0; c < 4; ++c) { Gj[c] = sc[16 * c + r]; Bj[c] = sc[64 + 16 * c + r]; }
            LAS float* lrow = Lm + (4 * q) * 64 + r;
#pragma unroll
            for (int a = 0; a < 4; ++a) { const f32x4 g4 = *(LAS const f32x4*)(sc + 16 * a + 4 * q), b4 = *(LAS const f32x4*)(sc + 64 + 16 * a + 4 * q);
#pragma unroll
                for (int c = 0; c < 4; ++c)
#pragma unroll
                    for (int e = 0; e < 4; ++e) {
                        const int i = 16 * a + 4 * q + e, j = 16 * c + r;
                        const float dg = dir == 0 ? g4[e] - Gj[c] : Gj[c] - g4[e], be = dir == 0 ? b4[e] : Bj[c];
                        const float val = (j < i) ? be * kk[a][c][e] * ex2(fminf(dg, 0.f)) : 0.f;
                        lrow[(16 * a + e) * 64 + 16 * c] = val;
                    } }
        }
        lds_wait();
        f32x2 x2[32];
#pragma unroll
        for (int i = 0; i < 32; ++i) x2[i] = (f32x2){0.f, 0.f};
        SolveRows<0>::run(x2, Lm, lane);
        lds_wait();
        LAS bf16_t* img = (LAS bf16_t*)kt;
        if (dir == 0) {
#pragma unroll
            for (int i = 0; i < 64; ++i) img[i * 64 + lane] = f2bf(x2[i >> 1][i & 1]);
        } else {
#pragma unroll
            for (int i = 0; i < 64; ++i) img[lane * 64 + i] = f2bf(x2[i >> 1][i & 1]);
        }
        lds_wait();
        bf16_t* dst = TI + ((size_t)(((b * NCHUNK + cid) * 8 + h) * 2 + dir)) * 4096;
#pragma unroll
        for (int t = 0; t < 8; ++t) { const int pcs = lane + 64 * t; *(u32x4*)(dst + pcs * 8) = *(LAS const u32x4*)(kt + pcs * 16); }
        lds_wait();
    }
}

constexpr int L_Q = 0, L_K = 17408, L_V = 34816, L_A = 44032, L_SB = 53248, L_X = 71680  , L_R = 80896, L_VN = 90112, L_VD = 99328,
              L_SC = 108544  , L_SSP = 109824;

struct Pre { u32x4 q0, q1, k0, k1, v, x; unsigned pa, pb; };

template <int DIR> DI void gla_prefetch(const Params& p, int b, int h, int s, int st, Pre& R) {
    const int tid = threadIdx.x, cid = chunk_id<DIR>(st);
    const bf16_t* P = (const bf16_t*)(p.ws + OFF_PSCAN) + (size_t)gla_base(b, cid) * NSCAN;
    const int i = tid >> 4, c16 = tid & 15;
    R.q0 = *(const u32x4*)(P + (size_t)i * NSCAN + 128 * h + 8 * c16); R.q1 = *(const u32x4*)(P + (size_t)(i + 32) * NSCAN + 128 * h + 8 * c16);
    R.k0 = *(const u32x4*)(P + (size_t)i * NSCAN + 512 + 128 * h + 8 * c16); R.k1 = *(const u32x4*)(P + (size_t)(i + 32) * NSCAN + 512 + 128 * h + 8 * c16);
    R.v = *(const u32x4*)(P + (size_t)(tid >> 3) * NSCAN + 1024 + 256 * h + 64 * s + 8 * (tid & 7));
    if (tid < 128) R.x = *(const u32x4*)(P + (size_t)(tid >> 1) * NSCAN + 5120 + 16 * DIR + 8 * (tid & 1));
}
template <int DIR> DI void gdn_prefetch(const Params& p, int b, int h, int s, int st, Pre& R) {
    const int tid = threadIdx.x, cid = chunk_id<DIR>(st);
    const bf16_t* P = (const bf16_t*)(p.ws + OFF_PSCAN);
    const int i = tid >> 4, c16 = tid & 15;
    const size_t r0 = (size_t)gdn_row(b, cid, i) * NSCAN, r1 = (size_t)gdn_row(b, cid, i + 32) * NSCAN;
    R.q0 = *(const u32x4*)(P + r0 + 2048 + 128 * h + 8 * c16); R.q1 = *(const u32x4*)(P + r1 + 2048 + 128 * h + 8 * c16);
    R.k0 = *(const u32x4*)(P + r0 + 3072 + 128 * h + 8 * c16); R.k1 = *(const u32x4*)(P + r1 + 3072 + 128 * h + 8 * c16);
    R.v = *(const u32x4*)(P + (size_t)gdn_row(b, cid, tid >> 3) * NSCAN + 4096 + 128 * h + 64 * s + 8 * (tid & 7));
    const bf16_t* TI = (const bf16_t*)(p.ws + OFF_TINV) + ((size_t)(((b * NCHUNK + cid) * 8 + h) * 2 + DIR)) * 4096;
    R.x = *(const u32x4*)(TI + tid * 8);
    if (tid < 64) { const bf16_t* rp = P + (size_t)gdn_row(b, cid, tid) * NSCAN + 5152 + 8 * DIR + h; R.pa = rp[0]; R.pb = rp[16]; }
}
DI void scan_stage0_common(LAS unsigned char* lds, const Pre& R, const f32x4 (&S)[4]) {
    const int tid = threadIdx.x, w = tid >> 6, lane = tid & 63, r = lane & 15, q = lane >> 4;
    const int i = tid >> 4, c16 = tid & 15;
    *(LAS u32x4*)(lds + L_Q + i * 272 + 16 * c16) = R.q0; *(LAS u32x4*)(lds + L_Q + (i + 32) * 272 + 16 * c16) = R.q1;
    *(LAS u32x4*)(lds + L_K + i * 272 + 16 * c16) = R.k0; *(LAS u32x4*)(lds + L_K + (i + 32) * 272 + 16 * c16) = R.k1;
    *(LAS u32x4*)(lds + L_V + (tid >> 3) * 144 + 16 * (tid & 7)) = R.v;
    const int dvt = w & 3, dh = w >> 2;
#pragma unroll
    for (int t = 0; t < 4; ++t) { const int d = 16 * (4 * dh + t) + r; *(LAS u32x2*)(lds + L_SB + d * 144 + (16 * dvt + 4 * q) * 2) = pack4(S[t]); }
}
DI void scan_out(bf16_t* op, f32x4 o, bool second, const u32x2 prev, LAS float* SSP, int i, int dvt, int q) {
    if (second) { o[0] += bflo(prev.x); o[1] += bfhi(prev.x); o[2] += bflo(prev.y); o[3] += bfhi(prev.y); }
    const u32x2 pk = pack4(o);
    *(u32x2*)op = pk;
    if (second) {
        const float a0 = bflo(pk.x), a1 = bfhi(pk.x), a2 = bflo(pk.y), a3 = bfhi(pk.y);
        float ssq = (a0 * a0 + a1 * a1) + (a2 * a2 + a3 * a3);
        ssq += __shfl_xor(ssq, 16); ssq += __shfl_xor(ssq, 32);
        if (q == 0) SSP[i * 4 + dvt] = ssq;
    }
}

template <int DIR> DI void gla_step(const Params& p, LAS unsigned char* lds, int b, int h, int s, int st, f32x4 (&S)[4], const bf16x8 lrw, const f32x4 lrbias, Pre& R) {
    const int tid = threadIdx.x, w = tid >> 6, lane = tid & 63, r = lane & 15, q = lane >> 4;
    const int cid = chunk_id<DIR>(st); const bool latent = cid >= 4; const int base = gla_base(b, cid);
    const bool second = latent && (DIR == 0 ? (cid - 4 >= 64) : (cid - 4 <= 63));
    LAS float* EG = (LAS float*)(lds + L_SC); LAS float* SSP = (LAS float*)(lds + L_SSP);
    const int dvt = w & 3, ih = w >> 2;
    bf16_t* const ob = (bf16_t*)p.out;
    u32x2 prev[2] = {{0u, 0u}, {0u, 0u}};
    if (second) {
#pragma unroll
        for (int u = 0; u < 2; ++u) prev[u] = *(const u32x2*)(ob + (size_t)(base + 16 * (2 * ih + u) + r) * 2048 + 256 * h + 64 * s + 16 * dvt + 4 * q);
    }
    scan_stage0_common(lds, R, S);
    if (tid < 128) *(LAS u32x4*)(lds + L_X + (tid >> 1) * 80 + 16 * (tid & 1)) = R.x;
    lds_barrier();
    if (DIR == 0) gla_prefetch<1>(p, b, h, s, st, R); else if (st + 1 < NCHUNK) gla_prefetch<0>(p, b, h, s, st + 1, R);
    {
        float g[4][4], Pfx[4][4], run[4] = {0.f, 0.f, 0.f, 0.f};
        const f32x4 zero = {0.f, 0.f, 0.f, 0.f};
        const int d0 = 16 * w + 4 * q;
#pragma unroll
        for (int t = 0; t < 4; ++t) {
            bf16x8 xf = {0, 0, 0, 0, 0, 0, 0, 0};
            if (q < 2) xf = ldsRow(lds + L_X + (16 * t + r) * 80 + 16 * q);
            const f32x4 z = mfma16(lrw, xf, zero);
#pragma unroll
            for (int j = 0; j < 4; ++j) { const float zz = z[j] + lrbias[j];
                g[t][j] = (fminf(zz, 0.f) * LOG2E - lg2(1.f + ex2(-LOG2E * fabsf(zz)))) * 0.0625f; }
        }
        u32x2 qv[4], kv[4];
#pragma unroll
        for (int t = 0; t < 4; ++t) { const int off = (16 * t + r) * 272 + 2 * d0; qv[t] = *(LAS const u32x2*)(lds + L_Q + off); kv[t] = *(LAS const u32x2*)(lds + L_K + off); }
#pragma unroll
        for (int t = 0; t < 4; ++t) {
#pragma unroll
            for (int j = 0; j < 4; ++j) {
                float v = g[t][j];
                v += __builtin_bit_cast(float, __builtin_amdgcn_update_dpp(0, __builtin_bit_cast(int, v), 0x111, 0xf, 0xf, false));
                v += __builtin_bit_cast(float, __builtin_amdgcn_update_dpp(0, __builtin_bit_cast(int, v), 0x112, 0xf, 0xf, false));
                v += __builtin_bit_cast(float, __builtin_amdgcn_update_dpp(0, __builtin_bit_cast(int, v), 0x114, 0xf, 0xf, false));
                v += __builtin_bit_cast(float, __builtin_amdgcn_update_dpp(0, __builtin_bit_cast(int, v), 0x118, 0xf, 0xf, false));
                Pfx[t][j] = run[j] + v;
                run[j] += __shfl(v, (lane & 48) | 15);
            }
        }
#pragma unroll
        for (int t = 0; t < 4; ++t) {
            float eq[4], ek[4];
#pragma unroll
            for (int j = 0; j < 4; ++j) { const float G = DIR == 0 ? Pfx[t][j] : run[j] - Pfx[t][j] + g[t][j]; eq[j] = ex2(G) * 0.08838834764831845f; ek[j] = ex2(-G); }
            u32x2 qo, ko;
            qo.x = pk2(bflo(qv[t].x) * eq[0], bfhi(qv[t].x) * eq[1]); qo.y = pk2(bflo(qv[t].y) * eq[2], bfhi(qv[t].y) * eq[3]);
            ko.x = pk2(bflo(kv[t].x) * ek[0], bfhi(kv[t].x) * ek[1]); ko.y = pk2(bflo(kv[t].y) * ek[2], bfhi(kv[t].y) * ek[3]);
            const int off = (16 * t + r) * 272 + 2 * d0;
            *(LAS u32x2*)(lds + L_Q + off) = qo; *(LAS u32x2*)(lds + L_K + off) = ko;
        }
        if (r == 0) { f32x4 e4; e4[0] = ex2(run[0]); e4[1] = ex2(run[1]); e4[2] = ex2(run[2]); e4[3] = ex2(run[3]); *(LAS f32x4*)(EG + d0) = e4; }
    }
    lds_barrier();
    if (latent) {
        const int it2 = w >> 1;
#pragma unroll
        for (int jj = 0; jj < 2; ++jj) {
            const int jt = 2 * (w & 1) + jj; const bool act = DIR == 0 ? (jt <= it2) : (jt >= it2);
            f32x4 acc = {0.f, 0.f, 0.f, 0.f};
            if (act) {
                bf16x8 fk[4], fq[4];
#pragma unroll
                for (int ks = 0; ks < 4; ++ks) { fk[ks] = ldsRow(lds + L_K + (16 * jt + r) * 272 + 64 * ks + 16 * q); fq[ks] = ldsRow(lds + L_Q + (16 * it2 + r) * 272 + 64 * ks + 16 * q); }
#pragma unroll
                for (int ks = 0; ks < 4; ++ks) acc = mfma16(fk[ks], fq[ks], acc);
            }
            const int i = 16 * it2 + r;
#pragma unroll
            for (int e = 0; e < 4; ++e) { const int j = 16 * jt + 4 * q + e; const bool keep = DIR == 0 ? (j <= i) : (j >= i); acc[e] = keep ? acc[e] : 0.f; }
            *(LAS u32x2*)(lds + L_A + i * 144 + (16 * jt + 4 * q) * 2) = pack4(acc);
        }
        lds_barrier();
        f32x4 o[2] = {{0.f, 0.f, 0.f, 0.f}, {0.f, 0.f, 0.f, 0.f}};
        {
            bf16x8 X[6], Y[6][2];
#pragma unroll
            for (int ks = 0; ks < 2; ++ks) { X[ks] = ldsT(lds + L_V, 144, 32 * ks, 16 * dvt, lane);
#pragma unroll
                for (int u = 0; u < 2; ++u) Y[ks][u] = ldsRow(lds + L_A + (16 * (2 * ih + u) + r) * 144 + 64 * ks + 16 * q); }
#pragma unroll
            for (int ks = 0; ks < 4; ++ks) { X[2 + ks] = ldsT(lds + L_SB, 144, 32 * ks, 16 * dvt, lane);
#pragma unroll
                for (int u = 0; u < 2; ++u) Y[2 + ks][u] = ldsRow(lds + L_Q + (16 * (2 * ih + u) + r) * 272 + 64 * ks + 16 * q); }
#pragma unroll
            for (int kk = 0; kk < 6; ++kk)
#pragma unroll
                for (int u = 0; u < 2; ++u) o[u] = mfma16(X[kk], Y[kk][u], o[u]);
        }
#pragma unroll
        for (int u = 0; u < 2; ++u) { const int i = 16 * (2 * ih + u) + r;
            scan_out(ob + (size_t)(base + i) * 2048 + 256 * h + 64 * s + 16 * dvt + 4 * q, o[u], second, prev[u], SSP, i, dvt, q); }
    }
    {
        bf16x8 X[2], Y[2][4];
#pragma unroll
        for (int ks = 0; ks < 2; ++ks) { X[ks] = ldsT(lds + L_V, 144, 32 * ks, 16 * dvt, lane);
#pragma unroll
            for (int t = 0; t < 4; ++t) Y[ks][t] = ldsT(lds + L_K, 272, 32 * ks, 16 * (4 * ih + t), lane); }
#pragma unroll
        for (int ks = 0; ks < 2; ++ks)
#pragma unroll
            for (int t = 0; t < 4; ++t) S[t] = mfma16(X[ks], Y[ks][t], S[t]);
    }
#pragma unroll
    for (int t = 0; t < 4; ++t) { const float eg = EG[16 * (4 * ih + t) + r]; S[t] = S[t] * eg; }
    lds_barrier();
    if (second && tid < 64) { const f32x4 s4 = *(LAS const f32x4*)(SSP + 4 * tid);
        ((float*)(p.ws + OFF_SS))[(size_t)(base + tid) * 32 + 4 * h + s] = (s4[0] + s4[1]) + (s4[2] + s4[3]); }
}

template <int DIR> DI void gdn_step(const Params& p, LAS unsigned char* lds, int b, int h, int s, int st, f32x4 (&S)[4], Pre& R, const float gA, const float gDt) {
    const int tid = threadIdx.x, w = tid >> 6, lane = tid & 63, r = lane & 15, q = lane >> 4;
    const int cid = chunk_id<DIR>(st); const bool latent = cid >= 4;
    const bool second = latent && (DIR == 0 ? (cid - 4 >= 64) : (cid - 4 <= 63));
    LAS float* sG = (LAS float*)(lds + L_SC); LAS float* sEG = sG + 64; LAS float* sBeta = sG + 128; LAS float* sEdec = sG + 192; LAS float* sEGend = sG + 256;
    LAS float* SSP = (LAS float*)(lds + L_SSP);
    const int dvt = w & 3, ih = w >> 2;
    bf16_t* const ob = (bf16_t*)p.out;
    u32x2 prev[2] = {{0u, 0u}, {0u, 0u}};
    if (second) {
#pragma unroll
        for (int u = 0; u < 2; ++u) prev[u] = *(const u32x2*)(ob + (size_t)gdn_row(b, cid, 16 * (2 * ih + u) + r) * 2048 + 1024 + 128 * h + 64 * s + 16 * dvt + 4 * q);
    }
    scan_stage0_common(lds, R, S);
    *(LAS u32x4*)(lds + L_X + (tid >> 3) * 144 + 16 * (tid & 7)) = R.x;
    if (tid < 64) {
        const float g2 = -gA * softplus_(bf2f((bf16_t)R.pa) + gDt) * LOG2E, beta = sigm(bf2f((bf16_t)R.pb));
        const float Pf = wave_prefix(g2, lane), Tall = __shfl(Pf, 63);
        const float G = DIR == 0 ? Pf : Tall - Pf + g2;
        sG[lane] = G; sEG[lane] = ex2(G); sBeta[lane] = beta; sEdec[lane] = ex2(Tall - G); if (lane == 0) sEGend[0] = ex2(Tall);
    }
    lds_barrier();
    if (DIR == 0) gdn_prefetch<1>(p, b, h, s, st, R); else if (st + 1 < NCHUNK) gdn_prefetch<0>(p, b, h, s, st + 1, R);
    {
        f32x4 pa[2] = {{0.f, 0.f, 0.f, 0.f}, {0.f, 0.f, 0.f, 0.f}};
        {
            bf16x8 X[4], Y[4][2];
#pragma unroll
            for (int ks = 0; ks < 4; ++ks) { X[ks] = ldsT(lds + L_SB, 144, 32 * ks, 16 * dvt, lane);
#pragma unroll
                for (int u = 0; u < 2; ++u) Y[ks][u] = ldsRow(lds + L_K + (16 * (2 * ih + u) + r) * 272 + 64 * ks + 16 * q); }
#pragma unroll
            for (int ks = 0; ks < 4; ++ks)
#pragma unroll
                for (int u = 0; u < 2; ++u) pa[u] = mfma16(X[ks], Y[ks][u], pa[u]);
        }
#pragma unroll
        for (int u = 0; u < 2; ++u) { const int i = 16 * (2 * ih + u) + r; const float eg = sEG[i], be = sBeta[i];
            const u32x2 vv = *(LAS const u32x2*)(lds + L_V + i * 144 + (16 * dvt + 4 * q) * 2);
            f32x4 rr; rr[0] = be * (bflo(vv.x) - eg * pa[u][0]); rr[1] = be * (bfhi(vv.x) - eg * pa[u][1]); rr[2] = be * (bflo(vv.y) - eg * pa[u][2]); rr[3] = be * (bfhi(vv.y) - eg * pa[u][3]);
            *(LAS u32x2*)(lds + L_R + i * 144 + (16 * dvt + 4 * q) * 2) = pack4(rr); }
    }
    if (latent) {
        const int it2 = w >> 1;
#pragma unroll
        for (int jj = 0; jj < 2; ++jj) {
            const int jt = 2 * (w & 1) + jj; const bool act = DIR == 0 ? (jt <= it2) : (jt >= it2);
            f32x4 acc = {0.f, 0.f, 0.f, 0.f};
            if (act) {
                bf16x8 fk[4], fq[4];
#pragma unroll
                for (int ks = 0; ks < 4; ++ks) { fk[ks] = ldsRow(lds + L_K + (16 * jt + r) * 272 + 64 * ks + 16 * q); fq[ks] = ldsRow(lds + L_Q + (16 * it2 + r) * 272 + 64 * ks + 16 * q); }
#pragma unroll
                for (int ks = 0; ks < 4; ++ks) acc = mfma16(fk[ks], fq[ks], acc);
            }
            const int i = 16 * it2 + r; const float Gi = sG[i]; const f32x4 Gj = *(LAS const f32x4*)(sG + 16 * jt + 4 * q);
#pragma unroll
            for (int e = 0; e < 4; ++e) { const int j = 16 * jt + 4 * q + e; const bool keep = DIR == 0 ? (j <= i) : (j >= i); acc[e] = keep ? acc[e] * ex2(fminf(Gi - Gj[e], 0.f)) : 0.f; }
            *(LAS u32x2*)(lds + L_A + i * 144 + (16 * jt + 4 * q) * 2) = pack4(acc);
        }
    }
    lds_barrier();
    {
        f32x4 va[2] = {{0.f, 0.f, 0.f, 0.f}, {0.f, 0.f, 0.f, 0.f}};
        {
            bf16x8 X[2], Y[2][2];
#pragma unroll
            for (int ks = 0; ks < 2; ++ks) { X[ks] = ldsT(lds + L_R, 144, 32 * ks, 16 * dvt, lane);
#pragma unroll
                for (int u = 0; u < 2; ++u) Y[ks][u] = ldsRow(lds + L_X + (16 * (2 * ih + u) + r) * 144 + 64 * ks + 16 * q); }
#pragma unroll
            for (int ks = 0; ks < 2; ++ks)
#pragma unroll
                for (int u = 0; u < 2; ++u) va[u] = mfma16(X[ks], Y[ks][u], va[u]);
        }
#pragma unroll
        for (int u = 0; u < 2; ++u) { const int i = 16 * (2 * ih + u) + r; const float ed = sEdec[i];
            *(LAS u32x2*)(lds + L_VN + i * 144 + (16 * dvt + 4 * q) * 2) = pack4(va[u]);
            *(LAS u32x2*)(lds + L_VD + i * 144 + (16 * dvt + 4 * q) * 2) = pack4(va[u] * ed); }
    }
    lds_barrier();
    if (latent) {
        f32x4 o[2] = {{0.f, 0.f, 0.f, 0.f}, {0.f, 0.f, 0.f, 0.f}};
        {
            bf16x8 X[6], Y[6][2]; float egs[2];
#pragma unroll
            for (int ks = 0; ks < 4; ++ks) { X[ks] = ldsT(lds + L_SB, 144, 32 * ks, 16 * dvt, lane);
#pragma unroll
                for (int u = 0; u < 2; ++u) Y[ks][u] = ldsRow(lds + L_Q + (16 * (2 * ih + u) + r) * 272 + 64 * ks + 16 * q); }
#pragma unroll
            for (int ks = 0; ks < 2; ++ks) { X[4 + ks] = ldsT(lds + L_VN, 144, 32 * ks, 16 * dvt, lane);
#pragma unroll
                for (int u = 0; u < 2; ++u) Y[4 + ks][u] = ldsRow(lds + L_A + (16 * (2 * ih + u) + r) * 144 + 64 * ks + 16 * q); }
#pragma unroll
            for (int u = 0; u < 2; ++u) egs[u] = sEG[16 * (2 * ih + u) + r];
#pragma unroll
            for (int ks = 0; ks < 4; ++ks)
#pragma unroll
                for (int u = 0; u < 2; ++u) o[u] = mfma16(X[ks], Y[ks][u], o[u]);
#pragma unroll
            for (int u = 0; u < 2; ++u) o[u] = o[u] * egs[u];
#pragma unroll
            for (int ks = 4; ks < 6; ++ks)
#pragma unroll
                for (int u = 0; u < 2; ++u) o[u] = mfma16(X[ks], Y[ks][u], o[u]);
        }
#pragma unroll
        for (int u = 0; u < 2; ++u) { const int i = 16 * (2 * ih + u) + r;
            scan_out(ob + (size_t)gdn_row(b, cid, i) * 2048 + 1024 + 128 * h + 64 * s + 16 * dvt + 4 * q, o[u], second, prev[u], SSP, i, dvt, q); }
    }
    {
        const float eg = sEGend[0];
#pragma unroll
        for (int t = 0; t < 4; ++t) S[t] = S[t] * eg;
        bf16x8 X[2], Y[2][4];
#pragma unroll
        for (int ks = 0; ks < 2; ++ks) { X[ks] = ldsT(lds + L_VD, 144, 32 * ks, 16 * dvt, lane);
#pragma unroll
            for (int t = 0; t < 4; ++t) Y[ks][t] = ldsT(lds + L_K, 272, 32 * ks, 16 * (4 * ih + t), lane); }
#pragma unroll
        for (int ks = 0; ks < 2; ++ks)
#pragma unroll
            for (int t = 0; t < 4; ++t) S[t] = mfma16(X[ks], Y[ks][t], S[t]);
    }
    lds_barrier();
    if (second && tid < 64) { const f32x4 s4 = *(LAS const f32x4*)(SSP + 4 * tid);
        ((float*)(p.ws + OFF_SS))[(size_t)gdn_row(b, cid, tid) * 32 + 16 + 2 * h + s] = (s4[0] + s4[1]) + (s4[2] + s4[3]); }
}

DI void phase_scan(const Params& p, LAS unsigned char* lds) {
    const int tid = threadIdx.x, w = tid >> 6, lane = tid & 63, r = lane & 15, q = lane >> 4;
    if ((blockIdx.x >> 3) >= 16) {
        const int xcd0 = blockIdx.x & 7, idx0 = blockIdx.x >> 3, rr = ((xcd0 * 8 + ((idx0 - 16) >> 1)) << 1) | (idx0 & 1);
        phase_tinv(p, lds, rr * 8, 1024);
        __syncthreads();
        if (tid == 0) {
            unsigned* ctr = (unsigned*)(p.ws + OFF_CTR);
            __threadfence();
            __hip_atomic_fetch_add(ctr, 1u, __ATOMIC_RELAXED, __HIP_MEMORY_SCOPE_AGENT);
            while (__hip_atomic_load(ctr, __ATOMIC_RELAXED, __HIP_MEMORY_SCOPE_AGENT) < 128u) __builtin_amdgcn_s_sleep(16);
            __threadfence();
        }
        __syncthreads();
    }
    for (int role0 = blockIdx.x; role0 < 256; role0 += gridDim.x) {
        int role = role0;
        if (gridDim.x == 256) { const int xcd = role0 & 7, idx = role0 >> 3; role = idx < 16 ? ((xcd * 4 + (idx >> 2)) << 2) | (idx & 3) : 128 + (((xcd * 8 + ((idx - 16) >> 1)) << 1) | (idx & 1)); }
        f32x4 Sf[4], Sb[4];
#pragma unroll
        for (int t = 0; t < 4; ++t) { Sf[t] = (f32x4){0.f, 0.f, 0.f, 0.f}; Sb[t] = (f32x4){0.f, 0.f, 0.f, 0.f}; }
        Pre R; R.q0 = R.q1 = R.k0 = R.k1 = R.v = R.x = (u32x4){0u, 0u, 0u, 0u}; R.pa = R.pb = 0u;
        __syncthreads();
        if (role < 128) {
            const int b = role >> 4, h = (role >> 2) & 3, s = role & 3;
            bf16x8 lw0 = {0, 0, 0, 0, 0, 0, 0, 0}, lw1 = {0, 0, 0, 0, 0, 0, 0, 0};
            const int d = 128 * h + 16 * w + r;
            if (q < 2) {
#pragma unroll
                for (int e = 0; e < 8; ++e) { lw0[e] = (short)f2bf(p.gla_lr_w[(size_t)(8 * q + e) * 512 + d]); lw1[e] = (short)f2bf(p.gla_lr_w[(size_t)(16 + 8 * q + e) * 512 + d]); }
            }
            const f32x4 lb0 = *(const f32x4*)(p.gla_lr_b + 128 * h + 16 * w + 4 * q), lb1 = *(const f32x4*)(p.gla_lr_b + 512 + 128 * h + 16 * w + 4 * q);
            gla_prefetch<0>(p, b, h, s, 0, R);
#pragma unroll 1
            for (int st = 0; st < NCHUNK; ++st) { gla_step<0>(p, lds, b, h, s, st, Sf, lw0, lb0, R); gla_step<1>(p, lds, b, h, s, st, Sb, lw1, lb1, R); }
        } else {
            const int rr = role - 128, b = rr >> 4, h = (rr >> 1) & 7, s = rr & 1;
            const float gA0 = __expf(p.gdn_a_log[h]), gA1 = __expf(p.gdn_a_log[8 + h]), gD0 = p.gdn_dt_bias[h], gD1 = p.gdn_dt_bias[8 + h];
            gdn_prefetch<0>(p, b, h, s, 0, R);
#pragma unroll 1
            for (int st = 0; st < NCHUNK; ++st) { gdn_step<0>(p, lds, b, h, s, st, Sf, R, gA0, gD0); gdn_step<1>(p, lds, b, h, s, st, Sb, R, gA1, gD1); }
        }
    }
}

#define XB_TMO      128
#define XB_XCNT(j)  (256  + 64 * (j))
#define XB_XSUB(j)  (1280 + 64 * (j))
#define XB_XGEN(j)  (2304 + 64 * (j))
#define XB_TOP      3328
#define XB_TOPGEN   3392
#define XCD_BAR_WORDS 3456
#define XB_SPIN_CAP (1u << 18)

__device__ __forceinline__ unsigned xb_ld(unsigned* p)              { return __hip_atomic_load(p, __ATOMIC_RELAXED, __HIP_MEMORY_SCOPE_AGENT); }
__device__ __forceinline__ unsigned xb_add(unsigned* p, unsigned v) { return __hip_atomic_fetch_add(p, v, __ATOMIC_RELAXED, __HIP_MEMORY_SCOPE_AGENT); }
__device__ __forceinline__ unsigned xb_xcc_id() { return (unsigned)__builtin_amdgcn_s_getreg((3 << 11) | 20) & 0xFu; }
#define XB_SPIN(cond, bar) do { unsigned _sp = 0; while (cond) { __builtin_amdgcn_s_sleep(1); \
    if ((++_sp & 255u) == 0u) { if (xb_ld(&(bar)[XB_TMO])) break; if (_sp > XB_SPIN_CAP) { atomicAdd(&(bar)[XB_TMO], 1u); break; } } } } while (0)

struct XcdBarrier {
    unsigned* bar; unsigned x;
    volatile LAS unsigned* st;
};

__device__ __forceinline__ XcdBarrier xcd_barrier_post(unsigned* bar, volatile LAS unsigned* st) {
    XcdBarrier b; b.bar = bar; b.x = xb_xcc_id(); b.st = st;
    if (threadIdx.x == 0) (void)xb_add(&bar[XB_XCNT(b.x)], 1u);
    return b;
}
__device__ __forceinline__ void xcd_barrier_complete(unsigned* bar, unsigned x, unsigned& nloc, unsigned& nx) {
    const unsigned G = gridDim.x * gridDim.y * gridDim.z;
    unsigned sum, cnt, mine, sp = 0u;
    for (;;) {
        sum = 0u; cnt = 0u; mine = 0u;
#pragma unroll
        for (unsigned j = 0; j < 16; ++j) { const unsigned c = xb_ld(&bar[XB_XCNT(j)]); sum += c; cnt += (c > 0u) ? 1u : 0u; mine = (j == x) ? c : mine; }
        if (sum == G) break;
        __builtin_amdgcn_s_sleep(1);
        if ((++sp & 255u) == 0u) { if (xb_ld(&bar[XB_TMO])) break; if (sp > XB_SPIN_CAP) { atomicAdd(&bar[XB_TMO], 1u); break; } }
    }
    nloc = mine > 0u ? mine : 1u; nx = cnt > 0u ? cnt : 1u;
}

__device__ __forceinline__ void xcd_barrier(const XcdBarrier& b) {
    asm volatile("s_waitcnt vmcnt(0)" ::: "memory");
    __syncthreads();
    if (threadIdx.x == 0) {
        unsigned* bar = b.bar;
        __builtin_amdgcn_s_waitcnt(0);
        unsigned nloc = b.st[0], nx = b.st[1];
        if (nloc == 0u) { xcd_barrier_complete(bar, b.x, nloc, nx); b.st[0] = nloc; b.st[1] = nx; }
        const unsigned old = xb_add(&bar[XB_XSUB(b.x)], 1u);
        const unsigned gen = old / nloc;
        if (old + 1u == (gen + 1u) * nloc) {
            __builtin_amdgcn_fence(__ATOMIC_RELEASE, "agent");
            asm volatile("s_waitcnt vmcnt(0)" ::: "memory");
            const unsigned og = xb_add(&bar[XB_TOP], 1u);
            const unsigned tg = og / nx;
            if (og + 1u == (tg + 1u) * nx) xb_add(&bar[XB_TOPGEN], 1u);
            else XB_SPIN(xb_ld(&bar[XB_TOPGEN]) == tg, bar);
            __builtin_amdgcn_fence(__ATOMIC_ACQUIRE, "agent");
            xb_add(&bar[XB_XGEN(b.x)], 1u);
            asm volatile("s_waitcnt vmcnt(0)" ::: "memory");
        } else {
            XB_SPIN(xb_ld(&bar[XB_XGEN(b.x)]) == gen, bar);
            __builtin_amdgcn_fence(__ATOMIC_ACQUIRE, "agent");
            asm volatile("s_waitcnt vmcnt(0)" ::: "memory");
        }
    }
    __syncthreads();
}

__global__ __launch_bounds__(512, 2) void mega(Params p) {
    extern __shared__ __attribute__((aligned(16))) unsigned char smem[];
    LAS unsigned char* lds = (LAS unsigned char*)smem;
    const int lo = p.ph_lo, hi = p.ph_hi;
#ifndef ONLY_PHASE
#define ONLY_PHASE -1
#endif
#define IN(k) ((ONLY_PHASE < 0 || ONLY_PHASE == (k)) && lo <= (k) && (k) < hi)
#define SEAM(k) do { if (IN(k) && IN((k) + 1)) xcd_barrier(xb); } while (0)
    volatile LAS unsigned* xst = (volatile LAS unsigned*)(lds + LDS_XB);
    if (threadIdx.x == 0) { xst[0] = 0u; xst[1] = 0u; }
    __syncthreads();
    const XcdBarrier xb = xcd_barrier_post((unsigned*)(p.ws + OFF_XBAR), xst);
    if (lo == -12345) cg::this_grid().sync();
    const int G = gridDim.x, c = blockIdx.x;
    if (IN(0)) phase0(p, lds);
    SEAM(0);
    if (IN(1)) phase_hn(p);
    SEAM(1);
    if (IN(2)) { pg8::Gemm g{(const bf16_t*)(p.ws + OFF_HN), (const bf16_t*)(p.ws + OFF_WSCAN), MALL, NSCAN_PAD, DM}; pg8::StaticOrder S; S.init(MALL, NSCAN_PAD, G, c);
        EpiScan E{(bf16_t*)(p.ws + OFF_PSCAN)}; pg8::gemm_phase<EpiScan, pg8::StaticOrder, GEMM_ALIGN, GEMM_SP2>(lds, g, S, E); }
    SEAM(2);
    if (IN(3)) phase_conv(p);
    SEAM(3);
    if (IN(5)) phase_scan(p, lds);
    SEAM(5);
    if (IN(6)) { pg8::Gemm g{(const bf16_t*)(p.ws + OFF_HN), (const bf16_t*)(p.ws + OFF_WMERGE), ML, NMERGE, DM}; pg8::StaticOrder S; S.init(ML, NMERGE, G, c);
        EpiMerge E{(const bf16_t*)p.out, (const float*)(p.ws + OFF_SS), p.gla_norm_w, p.gdn_norm_w, (bf16_t*)(p.ws + OFF_M)};
        pg8::gemm_phase<EpiMerge, pg8::StaticOrder, GEMM_ALIGN, GEMM_SP2>(lds, g, S, E); }
    SEAM(6);
    if (IN(7)) { pg8::Gemm g{(const bf16_t*)(p.ws + OFF_M), (const bf16_t*)(p.ws + OFF_WOUT), ML, DM, DM}; pg8::StaticOrder S; S.init(ML, DM, G, c);
        EpiY E{(const float*)(p.ws + OFF_MOD) + 2048, (bf16_t*)(p.ws + OFF_Y1)}; pg8::gemm_phase<EpiY, pg8::StaticOrder, GEMM_ALIGN, GEMM_SP2>(lds, g, S, E); }
    SEAM(7);
    if (IN(8)) phase_hn2(p);
    SEAM(8);
    if (IN(9)) { pg8::Gemm g{(const bf16_t*)(p.ws + OFF_HN), (const bf16_t*)(p.ws + OFF_WGU), ML, NGU, DM}; pg8::StaticOrder S; S.init(ML, NGU, G, c);
        EpiGU E{(bf16_t*)(p.ws + OFF_H)}; pg8::gemm_phase<EpiGU, pg8::StaticOrder, GEMM_ALIGN, GEMM_SP2>(lds, g, S, E); }
    SEAM(9);
    if (IN(10)) { pg8::Gemm g{(const bf16_t*)(p.ws + OFF_H), (const bf16_t*)(p.ws + OFF_WD), ML, DM, FFN}; pg8::StaticOrder S; S.init(ML, DM, G, c);
        EpiY E{(const float*)(p.ws + OFF_MOD) + 5120, (bf16_t*)(p.ws + OFF_Y2)}; pg8::gemm_phase<EpiY, pg8::StaticOrder, GEMM_ALIGN, GEMM_SP2>(lds, g, S, E); }
    SEAM(10);
    if (IN(11)) phase_final(p);
#undef IN
#undef SEAM
}

extern "C" void kernel_launch(void* const* d_in, const int* in_sizes, int n_in, void* d_out, int out_size, void* d_ws, size_t ws_size, hipStream_t stream) {
    static int grid = 0;
    if (grid == 0) {
        if (n_in != 21 || out_size != ML * DM || ws_size < WS_END + 4096 + 16384) { fprintf(stderr, "kernel_launch: unexpected shapes (n_in %d out %d ws %zu need %zu)\n", n_in, out_size, ws_size, (size_t)WS_END); grid = -1; return; }
        int dev = 0, cus = 0, per_cu = 0;
        hipGetDevice(&dev); hipDeviceGetAttribute(&cus, hipDeviceAttributeMultiprocessorCount, dev);
        if (hipFuncSetAttribute((const void*)mega, hipFuncAttributeMaxDynamicSharedMemorySize, LDS_BYTES) != hipSuccess) { fprintf(stderr, "kernel_launch: hipFuncSetAttribute failed\n"); grid = -1; return; }
        if (hipOccupancyMaxActiveBlocksPerMultiprocessor(&per_cu, (const void*)mega, 512, LDS_BYTES) != hipSuccess || per_cu < 1) { fprintf(stderr, "kernel_launch: occupancy query gave %d\n", per_cu); per_cu = 1; }
        (void)hipGetLastError();
        grid = cus * per_cu;
        if (grid != 256) { fprintf(stderr, "kernel_launch: this kernel is built for a 256-workgroup cooperative grid (256 CUs, one workgroup each); got %d\n", grid); grid = -1; return; }
    }
    if (grid < 0) return;
    (void)hipMemsetAsync((unsigned char*)d_ws + OFF_XBAR, 0, XCD_BAR_WORDS * 4, stream);
    Params p{};
    const float** pp = (const float**)&p;
    for (int i = 0; i < 21; ++i) pp[i] = (const float*)d_in[i];
    p.out = (float*)d_out; p.ws = (unsigned char*)d_ws;
#if N_LAUNCHES == 1
    p.ph_lo = 0; p.ph_hi = NPHASE;
    void* args[] = {&p};
    hipError_t e = hipLaunchCooperativeKernel((const void*)mega, dim3(grid), dim3(512), args, LDS_BYTES, stream);
    if (e != hipSuccess) fprintf(stderr, "kernel_launch: cooperative launch failed: %s (grid %d)\n", hipGetErrorString(e), grid);
#else
    for (int k = 0; k < NPHASE; ++k) { p.ph_lo = k; p.ph_hi = k + 1; hipLaunchKernelGGL(mega, dim3(grid), dim3(512), LDS_BYTES, stream, p); }
#endif
}
```
